# Optimizing an MI355X kernel written in HIP

```python
import jax, jax.numpy as jnp
from jax import lax
import numpy as np


D_MODEL = 1024
BATCH = 8
SEQ = 4096
DEPTH = 2

CHUNK = 64
EPS = 1e-6
PLE_DIM = 256
D_FF = 2816
FFN_RES = 0.5
N_EVEN = (DEPTH + 1) // 2
N_ODD = DEPTH // 2

GLA_HEADS = 4
GLA_V = D_MODEL // 2
GLA_DV = GLA_V // GLA_HEADS
GLA_QK = GLA_V // 2
GLA_DK = GLA_QK // GLA_HEADS
GLA_RANK = 16
GLA_GATE_TEMP = 16.0

LRU_WIDTH = D_MODEL // 2
LRU_BLOCKS = 8
LRU_BW = LRU_WIDTH // LRU_BLOCKS
CONV_W = 4
LRU_C = 8.0

MIX0_SPLITS = [int(c) for c in np.cumsum([GLA_QK, GLA_QK, GLA_V, GLA_V, GLA_RANK, LRU_WIDTH])]
MIX0_COLS = 2 * GLA_QK + 2 * GLA_V + GLA_RANK + 2 * LRU_WIDTH
MIX0_OUT = GLA_V + LRU_WIDTH

HG_DK = 128
HG_HEADS = D_MODEL // HG_DK
HG_DV = 128
HG_K = HG_HEADS * HG_DK
HG_V = HG_HEADS * HG_DV
MIX1_SPLITS = [HG_K, 2 * HG_K, 2 * HG_K + HG_V]
MIX1_COLS = 2 * HG_K + 2 * HG_V

kernel_name = 'hybrid_gla_rglru_hgrn2_macaron_ple'


def rmsnorm(x, g):
    xf = x.astype(jnp.float32)
    y = xf * lax.rsqrt(jnp.mean(xf * xf, axis=-1, keepdims=True) + EPS)
    return (y * g.astype(jnp.float32)).astype(x.dtype)


def swiglu(h, w1, w3, w2):
    return (jax.nn.silu(h @ w1) * (h @ w3)) @ w2


def chunk_end_gated_linear_attention(q, k, v, log_f):
    b, s, h, dk = q.shape
    dv = v.shape[-1]
    n = s // CHUNK

    def chunks(t):
        return jnp.moveaxis(t.astype(jnp.float32).reshape(b, n, CHUNK, h, t.shape[-1]), 1, 0)

    qc, kc, vc, lf = chunks(q), chunks(k), chunks(v), chunks(log_f)
    cum = jnp.cumsum(lf, axis=2)
    total = cum[:, :, -1]
    k_dec = kc * jnp.exp(total[:, :, None] - cum)
    g_chunk = jnp.exp(total)

    def step(state, xs):
        q_c, k_c, v_c, g_c = xs
        state = g_c[..., None] * state + jnp.einsum('bchk,bchv->bhkv', k_c, v_c)
        return state, jnp.einsum('bchk,bhkv->bchv', q_c, state)

    s0 = jnp.zeros((b, h, dk, dv), jnp.float32)
    _, o = lax.scan(step, s0, (qc, k_dec, vc, g_chunk))
    return jnp.moveaxis(o, 0, 1).reshape(b, s, h, dv).astype(v.dtype)


def causal_depthwise_conv(x, w, bias):
    s = x.shape[1]
    xp = jnp.pad(x, ((0, 0), (CONV_W - 1, 0), (0, 0)))
    out = xp[:, 0:s] * w[0]
    for j in range(1, CONV_W):
        out = out + xp[:, j:j + s] * w[j]
    return out + bias


def block_diag(x, w, bias):
    b, s, wd = x.shape
    xb = x.reshape(b, s, LRU_BLOCKS, LRU_BW)
    return jnp.einsum('bsgi,gij->bsgj', xb, w).reshape(b, s, wd) + bias


def rg_lru(x, w_a, b_a, w_x, b_x, lam):
    r = jax.nn.sigmoid(block_diag(x, w_a, b_a)).astype(jnp.float32)
    i = jax.nn.sigmoid(block_diag(x, w_x, b_x))
    log_a = LRU_C * r * jax.nn.log_sigmoid(lam.astype(jnp.float32))
    a = jnp.exp(log_a)
    u = jnp.sqrt(-jnp.expm1(2.0 * log_a)) * (i * x).astype(jnp.float32)

    def combine(left, right):
        a1, b1 = left
        a2, b2 = right
        return a1 * a2, a2 * b1 + b2

    _, hs = lax.associative_scan(combine, (a, u), axis=1)
    return hs.astype(x.dtype)


def mixer_gla_rglru(h, w_in, gla_gate_up, gla_gate_bias, gla_head_norm, conv_w, conv_b,
                    lru_wa, lru_ba, lru_wx, lru_bx, lru_lambda, w_out):
    b, s, _ = h.shape
    z = h @ w_in
    q, k, v, g, lr, xr, xg = jnp.split(z, MIX0_SPLITS, axis=-1)
    log_f = jax.nn.log_sigmoid((lr @ gla_gate_up + gla_gate_bias).astype(jnp.float32)) / GLA_GATE_TEMP
    o = chunk_end_gated_linear_attention(
        q.reshape(b, s, GLA_HEADS, GLA_DK) * (GLA_DK ** -0.5),
        k.reshape(b, s, GLA_HEADS, GLA_DK),
        v.reshape(b, s, GLA_HEADS, GLA_DV),
        log_f.reshape(b, s, GLA_HEADS, GLA_DK))
    o = rmsnorm(o, gla_head_norm).reshape(b, s, GLA_V) * jax.nn.silu(g)
    y = rg_lru(causal_depthwise_conv(xr, conv_w, conv_b), lru_wa, lru_ba, lru_wx, lru_bx, lru_lambda)
    y = y * jax.nn.gelu(xg)
    return jnp.concatenate([o, y], axis=-1) @ w_out


def mixer_hgrn2(h, w_in, lb, hg_head_norm, w_out):
    b, s, _ = h.shape
    z = h @ w_in
    q, fz, i, g = jnp.split(z, MIX1_SPLITS, axis=-1)
    lbf = lb.astype(jnp.float32)
    zf = fz.astype(jnp.float32)
    log_f = jnp.logaddexp(jnp.log(lbf), jnp.log1p(-lbf) + jax.nn.log_sigmoid(zf))
    k = (1.0 - lbf) * jax.nn.sigmoid(-zf)
    o = chunk_end_gated_linear_attention(
        jax.nn.silu(q).reshape(b, s, HG_HEADS, HG_DK),
        k.astype(h.dtype).reshape(b, s, HG_HEADS, HG_DK),
        i.reshape(b, s, HG_HEADS, HG_DV),
        log_f.reshape(b, s, HG_HEADS, HG_DK))
    o = rmsnorm(o, hg_head_norm).reshape(b, s, HG_V) * jax.nn.silu(g)
    return o @ w_out


def lower_bounds(lb_logits):
    sm = jax.nn.softmax(lb_logits.astype(jnp.float32), axis=0)
    return jnp.cumsum(sm, axis=0) - sm[0]


def half_ffn(x, g, w1, w3, w2):
    return x + FFN_RES * swiglu(rmsnorm(x, g), w1, w3, w2)


def setup_inputs(seed: int = 0) -> dict:
    key = jax.random.key(seed)
    ks = iter(list(jax.random.split(key, 40)))

    def nrm(shape, scale):
        return jax.random.normal(next(ks), shape, jnp.float32) * scale

    def gain(shape):
        return 1.0 + nrm(shape, 0.05)

    a0 = jax.random.uniform(next(ks), (N_EVEN, LRU_WIDTH), jnp.float32, 0.9, 0.999)
    return {
        'x': nrm((BATCH, SEQ, D_MODEL), 1.0),
        'p': nrm((DEPTH, BATCH, SEQ, PLE_DIM), 1.0),
        'ffn_norm': gain((DEPTH, 2, D_MODEL)),
        'ffn_w1': nrm((DEPTH, 2, D_MODEL, D_FF), D_MODEL ** -0.5),
        'ffn_w3': nrm((DEPTH, 2, D_MODEL, D_FF), D_MODEL ** -0.5),
        'ffn_w2': nrm((DEPTH, 2, D_FF, D_MODEL), D_FF ** -0.5),
        'mix_norm': gain((DEPTH, D_MODEL)),
        'ple_norm': gain((DEPTH, D_MODEL)),
        'ple_proj': nrm((DEPTH, PLE_DIM, D_MODEL), PLE_DIM ** -0.5),
        'ple_gate': nrm((DEPTH, D_MODEL, D_MODEL), D_MODEL ** -0.5),
        'final_norm': gain((D_MODEL,)),
        'm0_w_in': nrm((N_EVEN, D_MODEL, MIX0_COLS), D_MODEL ** -0.5),
        'gla_gate_up': nrm((N_EVEN, GLA_RANK, GLA_QK), GLA_RANK ** -0.5),
        'gla_gate_bias': nrm((N_EVEN, GLA_QK), 0.1),
        'gla_head_norm': gain((N_EVEN, GLA_DV)),
        'lru_conv_w': nrm((N_EVEN, CONV_W, LRU_WIDTH), CONV_W ** -0.5),
        'lru_conv_b': nrm((N_EVEN, LRU_WIDTH), 0.02),
        'lru_wa': nrm((N_EVEN, LRU_BLOCKS, LRU_BW, LRU_BW), LRU_BW ** -0.5),
        'lru_ba': nrm((N_EVEN, LRU_WIDTH), 0.02),
        'lru_wx': nrm((N_EVEN, LRU_BLOCKS, LRU_BW, LRU_BW), LRU_BW ** -0.5),
        'lru_bx': nrm((N_EVEN, LRU_WIDTH), 0.02),
        'lru_lambda': jnp.log(a0) - jnp.log1p(-a0),
        'm0_w_out': nrm((N_EVEN, MIX0_OUT, D_MODEL), MIX0_OUT ** -0.5),
        'm1_w_in': nrm((N_ODD, D_MODEL, MIX1_COLS), D_MODEL ** -0.5),
        'hgrn_lb_logits': nrm((DEPTH, HG_K), 0.1),
        'hgrn_head_norm': gain((N_ODD, HG_DV)),
        'm1_w_out': nrm((N_ODD, HG_V, D_MODEL), HG_V ** -0.5),
    }


def reference(x, p, ffn_norm, ffn_w1, ffn_w3, ffn_w2, mix_norm, ple_norm, ple_proj, ple_gate,
              final_norm, m0_w_in, gla_gate_up, gla_gate_bias, gla_head_norm, lru_conv_w,
              lru_conv_b, lru_wa, lru_ba, lru_wx, lru_bx, lru_lambda, m0_w_out, m1_w_in,
              hgrn_lb_logits, hgrn_head_norm, m1_w_out):
    lbs = lower_bounds(hgrn_lb_logits)
    for layer in range(DEPTH):
        x = half_ffn(x, ffn_norm[layer, 0], ffn_w1[layer, 0], ffn_w3[layer, 0], ffn_w2[layer, 0])
        h = rmsnorm(x, mix_norm[layer])
        if layer % 2 == 0:
            e = layer // 2
            x = x + mixer_gla_rglru(h, m0_w_in[e], gla_gate_up[e], gla_gate_bias[e], gla_head_norm[e],
                                    lru_conv_w[e], lru_conv_b[e], lru_wa[e], lru_ba[e], lru_wx[e],
                                    lru_bx[e], lru_lambda[e], m0_w_out[e])
        else:
            o = layer // 2
            x = x + mixer_hgrn2(h, m1_w_in[o], lbs[layer], hgrn_head_norm[o], m1_w_out[o])
        x = half_ffn(x, ffn_norm[layer, 1], ffn_w1[layer, 1], ffn_w3[layer, 1], ffn_w2[layer, 1])
        gate = jax.nn.sigmoid(rmsnorm(x, ple_norm[layer]) @ ple_gate[layer])
        x = x + gate * (p[layer] @ ple_proj[layer])
    return rmsnorm(x, final_norm)
```

```cpp
#include <hip/hip_runtime.h>
#include <hip/hip_cooperative_groups.h>
#include <cstdio>
#include <cstdint>
namespace cg = cooperative_groups;

#define LAS __attribute__((address_space(3)))
typedef unsigned short bf16_t;
typedef short bf16x8 __attribute__((ext_vector_type(8)));
typedef float f32x4 __attribute__((ext_vector_type(4)));
typedef float f32x2 __attribute__((ext_vector_type(2)));
typedef unsigned u32x4 __attribute__((ext_vector_type(4)));
typedef unsigned u32x2 __attribute__((ext_vector_type(2)));

constexpr int MTOK = 32768, DM = 1024, FF = 2816, SEQ = 4096, NCHUNK = 64;
constexpr float EPS = 1e-6f;
constexpr int LDZ0 = 2816, Q0 = 0, K0 = 256, V0 = 512, XG0 = 1024, XR0 = 1536, G0 = 2048, GP0 = 2560;
constexpr int LDZ1 = 4096, Q1 = 0, FZ1 = 1024, I1 = 2048, G1 = 3072;

constexpr size_t MiB = 1u << 20;
constexpr size_t WS_CTL = 0;
constexpr size_t WS_WUP = 1 * MiB;
constexpr size_t WS_WDN = 45 * MiB;
constexpr size_t WS_WIN0 = 67 * MiB;
constexpr size_t WS_WIN1 = 73 * MiB;
constexpr size_t WS_WOUT = 81 * MiB;
constexpr size_t WS_WGATE = 85 * MiB;
constexpr size_t WS_WPROJ = 89 * MiB;
constexpr size_t WS_WLRU = 90 * MiB;
constexpr size_t WS_SS0 = 91 * MiB;
constexpr size_t WS_SS1 = 93 * MiB;
constexpr size_t WS_GC = 95 * MiB;
constexpr size_t WS_SUMA = 97 * MiB;
constexpr size_t WS_SUMH = 98 * MiB;
constexpr size_t WS_XB = 100 * MiB;
constexpr size_t WS_Z = 164 * MiB;
constexpr size_t WS_KV0 = WS_Z + 176 * MiB;
constexpr size_t WS_PB = WS_Z + 208 * MiB;
constexpr size_t WS_END = WS_Z + 256 * MiB;

constexpr int LDS_BYTES = 147456;
constexpr int MISC_OFF = 143360;

__device__ __forceinline__ unsigned f2bf(float f) { unsigned u = __builtin_bit_cast(unsigned, f); return (u + 0x7fffu + ((u >> 16) & 1u)) >> 16; }
__device__ __forceinline__ unsigned pk2(float lo, float hi) { return f2bf(lo) | (f2bf(hi) << 16); }
__device__ __forceinline__ float bflo(unsigned w) { return __builtin_bit_cast(float, w << 16); }
__device__ __forceinline__ float bfhi(unsigned w) { return __builtin_bit_cast(float, w & 0xffff0000u); }
__device__ __forceinline__ float bf2f(bf16_t b) { return __builtin_bit_cast(float, ((unsigned)b) << 16); }
__device__ __forceinline__ unsigned cvt_pk_bf16(float lo, float hi) { unsigned r; asm volatile("v_cvt_pk_bf16_f32 %0, %1, %2" : "=v"(r) : "v"(lo), "v"(hi)); return r; }
__device__ __forceinline__ float fast_sigmoid(float x) { return __builtin_amdgcn_rcpf(1.0f + __builtin_amdgcn_exp2f(-1.44269504089f * x)); }
__device__ __forceinline__ float fast_silu(float x) { return x * fast_sigmoid(x); }
__device__ __forceinline__ float sigmoidf_(float x) { return 1.0f / (1.0f + expf(-x)); }
__device__ __forceinline__ float siluf_(float x) { return x / (1.0f + expf(-x)); }
__device__ __forceinline__ float logsigmoidf_(float x) { return fminf(x, 0.f) - log1pf(expf(-fabsf(x))); }
__device__ __forceinline__ float gelu_tanh(float x) { const float y = 0.7978845608028654f * (x + 0.044715f * x * x * x); const float t = 1.0f - 2.0f / (expf(2.0f * y) + 1.0f); return 0.5f * x * (1.0f + t); }

namespace pg8 {
constexpr int BM = 256, BK = 64, HALF = 128, HTB = HALF * BK * 2, STAGE_BYTES = 8 * HTB, NXCD = 8, WGM = 8;
__host__ __device__ __forceinline__ int lds_byte(int r, int c) { const int st = (r >> 4) * 2 + (c >> 5), rr = r & 15, cc = c & 31, ob = rr * 64 + cc * 2; return st * 1024 + (ob ^ (((ob >> 9) & 1) << 5)); }
__host__ __device__ __forceinline__ void stage_rc(int b, int& R, int& C) { const int st = b / 1024, sb = b % 1024, swz = sb ^ (((sb >> 9) & 1) << 5); R = (st >> 1) * 16 + swz / 64; C = (st & 1) * 32 + (swz % 64) / 2; }
__host__ __device__ __forceinline__ int perm32(int rho) { const int n = rho >> 4, i = rho & 15; return 8 * (i >> 2) + 4 * n + (i & 3); }
struct Unit { int pm, pn; };
struct Gemm { const bf16_t* A; const bf16_t* Bt; int M, N, K, lda; };
struct StaticOrder {
    int nM, nN, nwg, G, c;
    __device__ void init(int M, int N, int G_, int c_) { nM = M / BM; nN = N / BM; nwg = nM * nN; G = G_; c = c_; }
    __device__ bool next(int i, Unit& u) const {
        const long L = (long)i * G + c; if (L >= nwg) return false;
        int wgid = (int)L; { const int q = nwg / NXCD, r = nwg % NXCD, xcd = wgid % NXCD, off = wgid / NXCD; wgid = (xcd < r ? xcd * (q + 1) : r * (q + 1) + (xcd - r) * q) + off; }
        const int nig = WGM * nN, gid = wgid / nig, fm = gid * WGM, gsz = (nM - fm) < WGM ? (nM - fm) : WGM;
        u.pm = fm + ((wgid % nig) % gsz); u.pn = (wgid % nig) / gsz; return true;
    }
};

__device__ __forceinline__ float row_rstd(const float* SS, int row, int fq) {
    const f32x4 p = *(const f32x4*)(SS + (size_t)row * 16 + 4 * fq);
    float s = (p[0] + p[1]) + (p[2] + p[3]);
    s += __shfl_xor(s, 16); s += __shfl_xor(s, 32);
    return __builtin_amdgcn_rsqf(s * (1.0f / 1024.0f) + EPS);
}
struct EpiUp {
    bf16_t* U; const float* SS;
    __device__ __forceinline__ void operator()(const f32x4 (&acc)[2][2][4][2], const Unit& u, int wr, int wc, int fr, int fq) const {
        const int row0 = u.pm * BM + wr * 64 + fr, col0 = u.pn * 128 + wc * 32 + 8 * fq;
#pragma unroll
        for (int ai = 0; ai < 2; ++ai)
#pragma unroll
            for (int m = 0; m < 4; ++m) {
                const int row = row0 + ai * HALF + m * 16; const float r = row_rstd(SS, row, fq);
                const f32x4 a0 = acc[ai][0][m][0] * r, a1 = acc[ai][0][m][1] * r, g0 = acc[ai][1][m][0] * r, g1 = acc[ai][1][m][1] * r;
                u32x4 w;
                w.x = cvt_pk_bf16(fast_silu(a0[0]) * g0[0], fast_silu(a0[1]) * g0[1]); w.y = cvt_pk_bf16(fast_silu(a0[2]) * g0[2], fast_silu(a0[3]) * g0[3]);
                w.z = cvt_pk_bf16(fast_silu(a1[0]) * g1[0], fast_silu(a1[1]) * g1[1]); w.w = cvt_pk_bf16(fast_silu(a1[2]) * g1[2], fast_silu(a1[3]) * g1[3]);
                *(u32x4*)(U + (size_t)row * FF + col0) = w;
                asm volatile("" ::: "memory");
            }
    }
};
struct EpiZ {
    bf16_t* Z; int ldz; const float* SS;
    __device__ __forceinline__ void operator()(const f32x4 (&acc)[2][2][4][2], const Unit& u, int wr, int wc, int fr, int fq) const {
        const int row0 = u.pm * BM + wr * 64 + fr, col0 = u.pn * BM + wc * 32 + 8 * fq;
#pragma unroll
        for (int ai = 0; ai < 2; ++ai)
#pragma unroll
            for (int m = 0; m < 4; ++m) {
                const int row = row0 + ai * HALF + m * 16; const float r = row_rstd(SS, row, fq);
#pragma unroll
                for (int bj = 0; bj < 2; ++bj) {
                    const f32x4 v0 = acc[ai][bj][m][0] * r, v1 = acc[ai][bj][m][1] * r;
                    u32x4 w; w.x = cvt_pk_bf16(v0[0], v0[1]); w.y = cvt_pk_bf16(v0[2], v0[3]); w.z = cvt_pk_bf16(v1[0], v1[1]); w.w = cvt_pk_bf16(v1[2], v1[3]);
                    *(u32x4*)(Z + (size_t)row * ldz + col0 + bj * HALF) = w;
                }
                asm volatile("" ::: "memory");
            }
    }
};
struct EpiRes {
    const float* base; float* X; bf16_t* XB; float* SSo; float alpha;
    __device__ __forceinline__ void operator()(const f32x4 (&acc)[2][2][4][2], const Unit& u, int wr, int wc, int fr, int fq) const {
        const int row0 = u.pm * BM + wr * 64 + fr, col0 = u.pn * BM + wc * 32 + 8 * fq;
#pragma unroll
        for (int ai = 0; ai < 2; ++ai)
#pragma unroll
            for (int m = 0; m < 4; ++m) {
                const int row = row0 + ai * HALF + m * 16; float ssq = 0.f;
#pragma unroll
                for (int bj = 0; bj < 2; ++bj) {
                    const size_t off = (size_t)row * DM + col0 + bj * HALF;
                    const f32x4 b0 = *(const f32x4*)(base + off), b1 = *(const f32x4*)(base + off + 4);
                    const f32x4 v0 = b0 + acc[ai][bj][m][0] * alpha, v1 = b1 + acc[ai][bj][m][1] * alpha;
                    *(f32x4*)(X + off) = v0; *(f32x4*)(X + off + 4) = v1;
                    u32x4 w; w.x = cvt_pk_bf16(v0[0], v0[1]); w.y = cvt_pk_bf16(v0[2], v0[3]); w.z = cvt_pk_bf16(v1[0], v1[1]); w.w = cvt_pk_bf16(v1[2], v1[3]);
                    *(u32x4*)(XB + off) = w;
                    ssq += (v0[0] * v0[0] + v0[1] * v0[1]) + (v0[2] * v0[2] + v0[3] * v0[3]) + (v1[0] * v1[0] + v1[1] * v1[1]) + (v1[2] * v1[2] + v1[3] * v1[3]);
                }
                ssq += __shfl_xor(ssq, 16); ssq += __shfl_xor(ssq, 32);
                if (fq == 0) SSo[(size_t)row * 16 + u.pn * 4 + wc] = ssq;
                asm volatile("" ::: "memory");
            }
    }
};
struct EpiPP {
    float* PP;
    __device__ __forceinline__ void operator()(const f32x4 (&acc)[2][2][4][2], const Unit& u, int wr, int wc, int fr, int fq) const {
        const int row0 = u.pm * BM + wr * 64 + fr, col0 = u.pn * BM + wc * 32 + 8 * fq;
#pragma unroll
        for (int ai = 0; ai < 2; ++ai)
#pragma unroll
            for (int m = 0; m < 4; ++m) {
                const int row = row0 + ai * HALF + m * 16;
#pragma unroll
                for (int bj = 0; bj < 2; ++bj) { const size_t off = (size_t)row * DM + col0 + bj * HALF; *(f32x4*)(PP + off) = acc[ai][bj][m][0]; *(f32x4*)(PP + off + 4) = acc[ai][bj][m][1]; }
                asm volatile("" ::: "memory");
            }
    }
};
struct EpiPle {
    float* X; bf16_t* XB; const float* PP; const float* SSi; float* SSo;
    __device__ __forceinline__ void operator()(const f32x4 (&acc)[2][2][4][2], const Unit& u, int wr, int wc, int fr, int fq) const {
        const int row0 = u.pm * BM + wr * 64 + fr, col0 = u.pn * BM + wc * 32 + 8 * fq;
#pragma unroll
        for (int ai = 0; ai < 2; ++ai)
#pragma unroll
            for (int m = 0; m < 4; ++m) {
                const int row = row0 + ai * HALF + m * 16; const float r = row_rstd(SSi, row, fq); float ssq = 0.f;
#pragma unroll
                for (int bj = 0; bj < 2; ++bj) {
                    const size_t off = (size_t)row * DM + col0 + bj * HALF;
                    const f32x4 b0 = *(const f32x4*)(X + off), b1 = *(const f32x4*)(X + off + 4);
                    const f32x4 p0 = *(const f32x4*)(PP + off), p1 = *(const f32x4*)(PP + off + 4);
                    f32x4 v0, v1;
#pragma unroll
                    for (int e = 0; e < 4; ++e) { v0[e] = b0[e] + fast_sigmoid(acc[ai][bj][m][0][e] * r) * p0[e]; v1[e] = b1[e] + fast_sigmoid(acc[ai][bj][m][1][e] * r) * p1[e]; }
                    *(f32x4*)(X + off) = v0; *(f32x4*)(X + off + 4) = v1;
                    u32x4 w; w.x = cvt_pk_bf16(v0[0], v0[1]); w.y = cvt_pk_bf16(v0[2], v0[3]); w.z = cvt_pk_bf16(v1[0], v1[1]); w.w = cvt_pk_bf16(v1[2], v1[3]);
                    *(u32x4*)(XB + off) = w;
                    ssq += (v0[0] * v0[0] + v0[1] * v0[1]) + (v0[2] * v0[2] + v0[3] * v0[3]) + (v1[0] * v1[0] + v1[1] * v1[1]) + (v1[2] * v1[2] + v1[3] * v1[3]);
                }
                ssq += __shfl_xor(ssq, 16); ssq += __shfl_xor(ssq, 32);
                if (fq == 0) SSo[(size_t)row * 16 + u.pn * 4 + wc] = ssq;
                asm volatile("" ::: "memory");
            }
    }
};

template <class Epi>
__device__ __forceinline__ void gemm_phase(LAS unsigned char* lds, const Gemm g, const StaticOrder& S, const Epi& E) {
    int tid = threadIdx.x; asm volatile("" : "+v"(tid));
    const int wid = __builtin_amdgcn_readfirstlane(tid >> 6), lane = tid & 63, wr = wid >> 2, wc = wid & 3, fr = lane & 15, fq = lane >> 4;
    const int K = g.K, nt = K / BK, lda = g.lda;
    unsigned voffA[2], voffB[2];
#pragma unroll
    for (int i = 0; i < 2; ++i) { int R, C; stage_rc(tid * 16 + i * 8192, R, C); const int Rb = (R & ~31) + perm32(R & 31);
        voffA[i] = (unsigned)(R * lda + C) * 2u; voffB[i] = (unsigned)(Rb * K + C) * 2u; }
    const size_t kstep = (size_t)(BK * 2);
    const size_t hA = (size_t)HALF * lda * 2, hB = (size_t)HALF * K * 2;
    const size_t tA = 2 * hA, tB = 2 * hB;
    const unsigned ldsw = (unsigned)wid * 1024u;
    const int aoff = lds_byte(wr * 64 + fr, fq * 8), boff = lds_byte(wc * 32 + fr, fq * 8);
#define PG8_SA(b, h) (((b) * 2 + (h)) * HTB)
#define PG8_SB(b, h) ((4 + (b) * 2 + (h)) * HTB)
#define PG8_STAGE(bufoff, gbase, voff) do { _Pragma("unroll") for (int _i = 0; _i < 2; ++_i) \
        __builtin_amdgcn_global_load_lds((const unsigned*)((const char*)(gbase) + (voff)[_i]), (LAS unsigned*)(lds + (bufoff) + ldsw + _i * 8192), 16, 0, 0); } while (0)
#define PG8_LDA(dst, b, h) do { _Pragma("unroll") for (int m = 0; m < 4; ++m) _Pragma("unroll") for (int k = 0; k < 2; ++k) dst[m][k] = *(const LAS bf16x8*)(lds + PG8_SA(b, h) + aoff + m * 2048 + k * 1024); } while (0)
#define PG8_LDB(dst, b, h) do { _Pragma("unroll") for (int n = 0; n < 2; ++n) _Pragma("unroll") for (int k = 0; k < 2; ++k) dst[n][k] = *(const LAS bf16x8*)(lds + PG8_SB(b, h) + boff + n * 2048 + k * 1024); } while (0)
#define PG8_MMA(ai, bj, At, Bt) do { __builtin_amdgcn_s_setprio(1); _Pragma("unroll") for (int m = 0; m < 4; ++m) _Pragma("unroll") for (int n = 0; n < 2; ++n) _Pragma("unroll") for (int k = 0; k < 2; ++k) \
        acc[ai][bj][m][n] = __builtin_amdgcn_mfma_f32_16x16x32_bf16(Bt[n][k], At[m][k], acc[ai][bj][m][n], 0, 0, 0); __builtin_amdgcn_s_setprio(0); } while (0)
#define PG8_WAIT_V(n) asm volatile("s_waitcnt vmcnt(" #n ")" ::: "memory")
#define PG8_WAIT_L(n) asm volatile("s_waitcnt lgkmcnt(" #n ")" ::: "memory")
#define PG8_BAR __builtin_amdgcn_s_barrier()
#define PG8_SCHED __builtin_amdgcn_sched_barrier(0)
    Unit cur, nxt; int ui = 0;
    if (!S.next(0, cur)) return;
    f32x4 acc[2][2][4][2];
#pragma unroll
    for (int a = 0; a < 2; ++a)
#pragma unroll
        for (int b = 0; b < 2; ++b)
#pragma unroll
            for (int m = 0; m < 4; ++m)
#pragma unroll
                for (int n = 0; n < 2; ++n) acc[a][b][m][n] = (f32x4){0.f, 0.f, 0.f, 0.f};
    bf16x8 At[4][2], B0[2][2], B1[2][2];
    const char* cA = (const char*)g.A + (size_t)cur.pm * tA; const char* cB = (const char*)g.Bt + (size_t)cur.pn * tB;
    PG8_STAGE(PG8_SB(0, 0), cB, voffB); PG8_STAGE(PG8_SB(0, 1), cB + hB, voffB); PG8_STAGE(PG8_SA(0, 0), cA, voffA); PG8_STAGE(PG8_SA(0, 1), cA + hA, voffA);
    if (wr == 1) PG8_BAR;
    PG8_WAIT_V(2); PG8_BAR;
    PG8_STAGE(PG8_SB(1, 0), cB + kstep, voffB); PG8_STAGE(PG8_SA(1, 0), cA + kstep, voffA); PG8_STAGE(PG8_SB(1, 1), cB + hB + kstep, voffB);
    PG8_WAIT_V(6); PG8_BAR;
    for (;;) {
        const bool has_next = S.next(ui + 1, nxt);
        const char* nA = has_next ? (const char*)g.A + (size_t)nxt.pm * tA : cA; const char* nB = has_next ? (const char*)g.Bt + (size_t)nxt.pn * tB : cB;
#pragma unroll 1
        for (int t = 0; t < nt; t += 2) {
            const bool last = (t == nt - 2);
            const char* a1 = cA + (size_t)(t + 1) * kstep;
            const char* a2 = last ? nA : cA + (size_t)(t + 2) * kstep; const char* b2 = last ? nB : cB + (size_t)(t + 2) * kstep;
            const char* a3 = a2 + kstep; const char* b3 = b2 + kstep;
            PG8_LDB(B0, 0, 0); PG8_LDB(B1, 0, 1); PG8_SCHED; PG8_LDA(At, 0, 0); PG8_STAGE(PG8_SA(1, 1), a1 + hA, voffA);
            PG8_WAIT_V(8); PG8_WAIT_L(0); PG8_BAR; PG8_MMA(0, 0, At, B0); PG8_MMA(0, 1, At, B1); PG8_BAR; PG8_SCHED;
            PG8_LDA(At, 0, 1); PG8_STAGE(PG8_SB(0, 0), b2, voffB); PG8_STAGE(PG8_SB(0, 1), b2 + hB, voffB); PG8_STAGE(PG8_SA(0, 0), a2, voffA);
            PG8_WAIT_V(8); PG8_WAIT_L(0); PG8_BAR; PG8_MMA(1, 0, At, B0); PG8_MMA(1, 1, At, B1); PG8_BAR; PG8_SCHED;
            PG8_LDB(B0, 1, 0); PG8_LDB(B1, 1, 1); PG8_SCHED; PG8_LDA(At, 1, 0); PG8_STAGE(PG8_SA(0, 1), a2 + hA, voffA);
            PG8_WAIT_V(8); PG8_WAIT_L(0); PG8_BAR; PG8_MMA(0, 0, At, B0); PG8_MMA(0, 1, At, B1); PG8_BAR; PG8_SCHED;
            PG8_LDA(At, 1, 1); PG8_STAGE(PG8_SB(1, 0), b3, voffB); PG8_STAGE(PG8_SB(1, 1), b3 + hB, voffB); PG8_STAGE(PG8_SA(1, 0), a3, voffA);
            PG8_WAIT_V(8); PG8_WAIT_L(0); PG8_BAR; PG8_MMA(1, 0, At, B0); PG8_MMA(1, 1, At, B1); PG8_BAR; PG8_SCHED;
        }
        if (wr == 0) PG8_BAR;
        E(acc, cur, wr, wc, fr, fq);
        if (!has_next) break;
#pragma unroll
        for (int a = 0; a < 2; ++a)
#pragma unroll
            for (int b = 0; b < 2; ++b)
#pragma unroll
                for (int m = 0; m < 4; ++m)
#pragma unroll
                    for (int n = 0; n < 2; ++n) acc[a][b][m][n] = (f32x4){0.f, 0.f, 0.f, 0.f};
        cur = nxt; cA = nA; cB = nB; ++ui;
        if (wr == 1) PG8_BAR;
    }
    PG8_WAIT_V(0);
    PG8_BAR;
#undef PG8_SA
#undef PG8_SB
#undef PG8_STAGE
#undef PG8_LDA
#undef PG8_LDB
#undef PG8_MMA
#undef PG8_WAIT_V
#undef PG8_WAIT_L
#undef PG8_BAR
#undef PG8_SCHED
}
}

#define XB_TMO      128
#define XB_XCNT(j)  (256  + 64 * (j))
#define XB_XSUB(j)  (1280 + 64 * (j))
#define XB_XGEN(j)  (2304 + 64 * (j))
#define XB_TOP      3328
#define XB_TOPGEN   3392
#define XCD_BAR_WORDS 3456
#define XB_SPIN_CAP (1u << 22)
__device__ __forceinline__ unsigned xb_ld(unsigned* p)              { return __hip_atomic_load(p, __ATOMIC_RELAXED, __HIP_MEMORY_SCOPE_AGENT); }
__device__ __forceinline__ unsigned xb_add(unsigned* p, unsigned v) { return __hip_atomic_fetch_add(p, v, __ATOMIC_RELAXED, __HIP_MEMORY_SCOPE_AGENT); }
__device__ __forceinline__ unsigned xb_xcc_id() { return (unsigned)__builtin_amdgcn_s_getreg((3 << 11) | 20) & 0xFu; }
#define XB_SPIN(cond, bar) do { unsigned _sp = 0; while (cond) { __builtin_amdgcn_s_sleep(1); \
    if ((++_sp & 255u) == 0u) { if (xb_ld(&(bar)[XB_TMO])) break; if (_sp > XB_SPIN_CAP) { atomicAdd(&(bar)[XB_TMO], 1u); break; } } } } while (0)
struct XcdBarrier { unsigned* bar; unsigned x; volatile LAS unsigned* st; };
__device__ __forceinline__ XcdBarrier xcd_barrier_post(unsigned* bar, volatile LAS unsigned* st) {
    XcdBarrier b; b.bar = bar; b.x = xb_xcc_id(); b.st = st;
    if (threadIdx.x == 0) (void)xb_add(&bar[XB_XCNT(b.x)], 1u);
    return b;
}
__device__ __forceinline__ void xcd_barrier_complete(unsigned* bar, unsigned x, unsigned& nloc, unsigned& nx) {
    const unsigned G = gridDim.x * gridDim.y * gridDim.z;
    unsigned sum, cnt, mine, sp = 0u;
    for (;;) {
        sum = 0u; cnt = 0u; mine = 0u;
#pragma unroll
        for (unsigned j = 0; j < 16; ++j) { const unsigned c = xb_ld(&bar[XB_XCNT(j)]); sum += c; cnt += (c > 0u) ? 1u : 0u; mine = (j == x) ? c : mine; }
        if (sum == G) break;
        __builtin_amdgcn_s_sleep(1);
        if ((++sp & 255u) == 0u) { if (xb_ld(&bar[XB_TMO])) break; if (sp > XB_SPIN_CAP) { atomicAdd(&bar[XB_TMO], 1u); break; } }
    }
    nloc = mine > 0u ? mine : 1u; nx = cnt > 0u ? cnt : 1u;
}
__device__ __forceinline__ void xcd_barrier(const XcdBarrier& b) {
    asm volatile("s_waitcnt vmcnt(0)" ::: "memory");
    __syncthreads();
    if (threadIdx.x == 0) {
        unsigned* bar = b.bar;
        __builtin_amdgcn_s_waitcnt(0);
        unsigned nloc = b.st[0], nx = b.st[1];
        if (nloc == 0u) { xcd_barrier_complete(bar, b.x, nloc, nx); b.st[0] = nloc; b.st[1] = nx; }
        const unsigned old = xb_add(&bar[XB_XSUB(b.x)], 1u);
        const unsigned gen = old / nloc;
        if (old + 1u == (gen + 1u) * nloc) {
            __builtin_amdgcn_fence(__ATOMIC_RELEASE, "agent");
            asm volatile("s_waitcnt vmcnt(0)" ::: "memory");
            const unsigned og = xb_add(&bar[XB_TOP], 1u);
            const unsigned tg = og / nx;
            if (og + 1u == (tg + 1u) * nx) xb_add(&bar[XB_TOPGEN], 1u);
            else XB_SPIN(xb_ld(&bar[XB_TOPGEN]) == tg, bar);
            __builtin_amdgcn_fence(__ATOMIC_ACQUIRE, "agent");
            xb_add(&bar[XB_XGEN(b.x)], 1u);
            asm volatile("s_waitcnt vmcnt(0)" ::: "memory");
        } else {
            XB_SPIN(xb_ld(&bar[XB_XGEN(b.x)]) == gen, bar);
            __builtin_amdgcn_fence(__ATOMIC_ACQUIRE, "agent");
            asm volatile("s_waitcnt vmcnt(0)" ::: "memory");
        }
    }
    __syncthreads();
}

struct Args { const float* in[27]; float* out; unsigned char* ws; };

__device__ __forceinline__ float wave_sum(float v) {
#pragma unroll
    for (int o = 1; o < 64; o <<= 1) v += __shfl_xor(v, o);
    return v;
}

__device__ __forceinline__ void tr_item(const float* src, int ld, int c0, int k0, bf16_t* dst, int K, int r0, const float* gain, float scale, LAS float* scr, int lane) {
#pragma unroll 8
    for (int i = 0; i < 32; ++i) { const int kk = 2 * i + (lane >> 5); scr[kk * 33 + (lane & 31)] = src[(size_t)(k0 + kk) * ld + c0 + (lane & 31)]; }
    asm volatile("s_waitcnt lgkmcnt(0)" ::: "memory");
    const int c = lane & 7;
    float gv[8];
#pragma unroll
    for (int e = 0; e < 8; ++e) gv[e] = gain ? gain[k0 + 8 * c + e] * scale : scale;
#pragma unroll
    for (int j = 0; j < 4; ++j) { const int n = (lane >> 3) + 8 * j; const LAS float* s = scr + (8 * c) * 33 + n;
        u32x4 o; o.x = pk2(s[0 * 33] * gv[0], s[1 * 33] * gv[1]); o.y = pk2(s[2 * 33] * gv[2], s[3 * 33] * gv[3]); o.z = pk2(s[4 * 33] * gv[4], s[5 * 33] * gv[5]); o.w = pk2(s[6 * 33] * gv[6], s[7 * 33] * gv[7]);
        *(u32x4*)(dst + (size_t)(r0 + n) * K + k0 + 8 * c) = o; }
    asm volatile("s_waitcnt lgkmcnt(0)" ::: "memory");
}

constexpr int IT_UP = 4 * 2816, IT_DN = 4 * 1408, IT_IN0 = 1280, IT_IN1 = 2048, IT_SQ = 4 * 512, IT_PROJ = 256, IT_GP = 128, IT_LRU = 32;
constexpr int IT_TOTAL = IT_UP + IT_DN + IT_IN0 + IT_IN1 + IT_SQ + IT_PROJ + IT_GP + IT_LRU;

__device__ __forceinline__ void pre_phase(const Args& a, LAS unsigned char* lds, int vcu, int wave, int lane) {
    unsigned char* ws = a.ws;
    LAS float* scr = (LAS float*)(lds + wave * 16384);
    const int gw = vcu * 8 + wave, NGW = 256 * 8;
    for (int it = gw; it < IT_TOTAL; it += NGW) {
        int r = it;
        if (r < IT_UP) { const int mat = r / 2816, q = r % 2816, rb = q / 16, kb = q % 16, pn = rb / 8, half = (rb % 8) / 4, jb = rb % 4;
            const float* src = (half ? a.in[4] : a.in[3]) + (size_t)mat * DM * FF;
            tr_item(src, FF, 128 * pn + 32 * jb, 64 * kb, (bf16_t*)(ws + WS_WUP) + (size_t)mat * 5632 * DM, DM, 32 * rb, a.in[2] + mat * DM, 1.0f, scr, lane); continue; }
        r -= IT_UP;
        if (r < IT_DN) { const int mat = r / 1408, q = r % 1408, rb = q / 44, kb = q % 44;
            tr_item(a.in[5] + (size_t)mat * FF * DM, DM, 32 * rb, 64 * kb, (bf16_t*)(ws + WS_WDN) + (size_t)mat * DM * FF, FF, 32 * rb, nullptr, 1.0f, scr, lane); continue; }
        r -= IT_DN;
        if (r < IT_IN0) { const int rb = r / 16, kb = r % 16, row = 32 * rb; int c0; float sc = 1.0f;
            if (row < 256) { c0 = row; sc = 0.125f; } else if (row < 1024) c0 = row; else if (row < 1536) c0 = 2064 + (row - 1024); else if (row < 2048) c0 = 1552 + (row - 1536); else c0 = 1024 + (row - 2048);
            tr_item(a.in[11], 2576, c0, 64 * kb, (bf16_t*)(ws + WS_WIN0), DM, row, a.in[6], sc, scr, lane); continue; }
        r -= IT_IN0;
        if (r < IT_IN1) { const int rb = r / 16, kb = r % 16;
            tr_item(a.in[23], 4096, 32 * rb, 64 * kb, (bf16_t*)(ws + WS_WIN1), DM, 32 * rb, a.in[6] + DM, 1.0f, scr, lane); continue; }
        r -= IT_IN1;
        if (r < IT_SQ) { const int mat = r / 512, q = r % 512, rb = q / 16, kb = q % 16;
            const float* src = mat == 0 ? a.in[22] : mat == 1 ? a.in[26] : mat == 2 ? a.in[9] : a.in[9] + (size_t)DM * DM;
            bf16_t* dst = mat < 2 ? (bf16_t*)(ws + WS_WOUT) + (size_t)mat * DM * DM : (bf16_t*)(ws + WS_WGATE) + (size_t)(mat - 2) * DM * DM;
            const float* gn = mat < 2 ? nullptr : a.in[7] + (mat - 2) * DM;
            tr_item(src, DM, 32 * rb, 64 * kb, dst, DM, 32 * rb, gn, 1.0f, scr, lane); continue; }
        r -= IT_SQ;
        if (r < IT_PROJ) { const int mat = r / 128, q = r % 128, rb = q / 4, kb = q % 4;
            tr_item(a.in[8] + (size_t)mat * 256 * DM, DM, 32 * rb, 64 * kb, (bf16_t*)(ws + WS_WPROJ) + (size_t)mat * DM * 256, 256, 32 * rb, nullptr, 1.0f, scr, lane); continue; }
        r -= IT_PROJ;
        if (r < IT_GP) {
            const int nb = r / 16, kb = r % 16, c = lane & 7; const float* win = a.in[11]; const float* gu = a.in[12]; const float* gn = a.in[6];
#pragma unroll 1
            for (int j = 0; j < 4; ++j) { const int n = 32 * nb + (lane >> 3) + 8 * j; float o[8];
#pragma unroll
                for (int e = 0; e < 8; ++e) { const int k = 64 * kb + 8 * c + e; float s = 0.f;
#pragma unroll
                    for (int rr = 0; rr < 16; ++rr) s += win[(size_t)k * 2576 + 1536 + rr] * gu[rr * 256 + n];
                    o[e] = s * gn[k]; }
                u32x4 w; w.x = pk2(o[0], o[1]); w.y = pk2(o[2], o[3]); w.z = pk2(o[4], o[5]); w.w = pk2(o[6], o[7]);
                *(u32x4*)((bf16_t*)(ws + WS_WIN0) + (size_t)(GP0 + n) * DM + 64 * kb + 8 * c) = w; }
            continue; }
        r -= IT_GP;
        { const int mat = r / 16, q = r % 16, g = q / 2, rb = q % 2;
            tr_item((mat ? a.in[19] : a.in[17]) + g * 4096, 64, 32 * rb, 0, (bf16_t*)(ws + WS_WLRU) + mat * 32768 + g * 4096, 64, 32 * rb, nullptr, 1.0f, scr, lane); }
    }
    const float* x = a.in[0]; bf16_t* XB = (bf16_t*)(ws + WS_XB); float* SS = (float*)(ws + WS_SS0);
    for (int m = gw; m < MTOK; m += NGW) {
        const f32x4* xr = (const f32x4*)(x + (size_t)m * DM) + lane; float s = 0.f; f32x4 v[4];
#pragma unroll
        for (int j = 0; j < 4; ++j) { v[j] = xr[64 * j]; s += (v[j][0] * v[j][0] + v[j][1] * v[j][1]) + (v[j][2] * v[j][2] + v[j][3] * v[j][3]); }
        s = wave_sum(s);
        u32x2* o = (u32x2*)(XB + (size_t)m * DM) + lane;
#pragma unroll
        for (int j = 0; j < 4; ++j) { u32x2 w; w.x = pk2(v[j][0], v[j][1]); w.y = pk2(v[j][2], v[j][3]); o[64 * j] = w; }
        if (lane < 16) SS[(size_t)m * 16 + lane] = lane == 0 ? s : 0.f;
    }
}

__device__ __forceinline__ void pconv_phase(const float* p, bf16_t* PB, int gtid) {
    const f32x4* src = (const f32x4*)p; u32x2* dst = (u32x2*)PB;
    for (int i = gtid; i < MTOK * 256 / 4; i += 256 * 512) { const f32x4 v = src[i]; u32x2 w; w.x = pk2(v[0], v[1]); w.y = pk2(v[2], v[3]); dst[i] = w; }
}

template <int L>
__device__ __forceinline__ void p1_task(const Args& a, LAS unsigned char* lds, int task, int tid) {
    constexpr int DK = L ? 128 : 64, H = L ? 8 : 4, SEGS = 512 / DK, TPS = 64 / SEGS, LDZ = L ? LDZ1 : LDZ0;
    unsigned char* ws = a.ws;
    bf16_t* Z = (bf16_t*)(ws + WS_Z);
    float* GC = (float*)(ws + WS_GC);
    const int h = task % H; const size_t tok0 = (size_t)(task / H) * 64;
    LAS bf16_t* KD = (LAS bf16_t*)lds;
    LAS bf16_t* VT = (LAS bf16_t*)(lds + 128 * 144);
    LAS float* SEG = (LAS float*)(lds + 2 * 128 * 144);
    const int lane = tid & 63, wid = tid >> 6;
    {
        const int d = tid % DK, seg = tid / DK;
        float lf[TPS], kk[TPS];
        if (L == 0) {
            const float bias = a.in[13][64 * h + d];
#pragma unroll
            for (int i = 0; i < TPS; ++i) { const size_t rowo = (tok0 + seg * TPS + i) * LDZ;
                const float gp = bf2f(Z[rowo + GP0 + 64 * h + d]) + bias; lf[i] = logsigmoidf_(gp) * (1.0f / 16.0f); kk[i] = bf2f(Z[rowo + K0 + 64 * h + d]); }
        } else {
            const float l0 = a.in[24][128 * h + d], l1 = a.in[24][1024 + 128 * h + d]; const float lb = sigmoidf_(l1 - l0);
#pragma unroll
            for (int i = 0; i < TPS; ++i) { const size_t rowo = (tok0 + seg * TPS + i) * LDZ;
                const float zz = bf2f(Z[rowo + FZ1 + 128 * h + d]); const float sg = sigmoidf_(zz);
                lf[i] = logf(lb + (1.0f - lb) * sg); kk[i] = (1.0f - lb) * (1.0f - sg); }
        }
        float run = 0.f;
#pragma unroll
        for (int i = 0; i < TPS; ++i) { run += lf[i]; lf[i] = run; }
        SEG[seg * DK + d] = run;
        __syncthreads();
        float off = 0.f, total = 0.f;
#pragma unroll
        for (int s = 0; s < SEGS; ++s) { const float v = SEG[s * DK + d]; total += v; off += (s < seg) ? v : 0.f; }
        unsigned w[TPS / 2];
#pragma unroll
        for (int i = 0; i < TPS; i += 2) w[i / 2] = pk2(kk[i] * expf(total - (off + lf[i])), kk[i + 1] * expf(total - (off + lf[i + 1])));
#pragma unroll
        for (int i = 0; i < TPS / 8; ++i) { u32x4 o; o.x = w[4 * i]; o.y = w[4 * i + 1]; o.z = w[4 * i + 2]; o.w = w[4 * i + 3];
            *(LAS u32x4*)(KD + d * 72 + seg * TPS + 8 * i) = o; }
        if (seg == 0) GC[(size_t)task * DK + d] = expf(total);
    }
    {
        const int dv = tid & 127, tq = tid >> 7; const int vcol = (L ? I1 : V0) + 128 * h + dv;
        unsigned w[8];
#pragma unroll
        for (int i = 0; i < 16; i += 2) { const unsigned lo = Z[(tok0 + 16 * tq + i) * LDZ + vcol], hi = Z[(tok0 + 16 * tq + i + 1) * LDZ + vcol]; w[i / 2] = lo | (hi << 16); }
        u32x4 o0, o1; o0.x = w[0]; o0.y = w[1]; o0.z = w[2]; o0.w = w[3]; o1.x = w[4]; o1.y = w[5]; o1.z = w[6]; o1.w = w[7];
        *(LAS u32x4*)(VT + dv * 72 + 16 * tq) = o0; *(LAS u32x4*)(VT + dv * 72 + 16 * tq + 8) = o1;
    }
    __syncthreads();
    {
        const int cj = lane & 15, q = lane >> 4;
        bf16x8 vf[2];
#pragma unroll
        for (int ks = 0; ks < 2; ++ks) vf[ks] = *(const LAS bf16x8*)(VT + (16 * wid + cj) * 72 + 32 * ks + 8 * q);
#pragma unroll
        for (int kt = 0; kt < DK / 16; ++kt) {
            f32x4 acc = (f32x4){0.f, 0.f, 0.f, 0.f};
#pragma unroll
            for (int ks = 0; ks < 2; ++ks) { const bf16x8 kf = *(const LAS bf16x8*)(KD + (16 * kt + cj) * 72 + 32 * ks + 8 * q);
                acc = __builtin_amdgcn_mfma_f32_16x16x32_bf16(kf, vf[ks], acc, 0, 0, 0); }
            u32x2 o; o.x = pk2(acc[0], acc[1]); o.y = pk2(acc[2], acc[3]);
            const int dv = 16 * wid + cj, dk = 16 * kt + 4 * q;
            if (L == 0) *(u32x2*)((bf16_t*)(ws + WS_KV0) + ((size_t)task * 128 + dv) * 64 + dk) = o;
            else *(u32x2*)(Z + (tok0 + (dv & 63)) * LDZ + (dv < 64 ? FZ1 : I1) + 128 * h + dk) = o;
        }
    }
    __syncthreads();
}

template <int L>
__device__ __forceinline__ void p2_phase(const Args& a, int gtid) {
    constexpr int DK = L ? 128 : 64, H = L ? 8 : 4, DKG = DK / 8, LDZ = L ? LDZ1 : LDZ0;
    constexpr int NTHR = 8 * H * 128 * DKG;
    unsigned char* ws = a.ws;
    if (gtid >= NTHR) return;
    const int dkg = gtid % DKG, dv = (gtid / DKG) % 128, bh = gtid / (DKG * 128), h = bh % H, b = bh / H;
    const float* GC = (const float*)(ws + WS_GC);
    bf16_t* base; size_t cstride;
    if (L == 0) { base = (bf16_t*)(ws + WS_KV0) + (((size_t)(b * 64) * 4 + h) * 128 + dv) * 64 + 8 * dkg; cstride = (size_t)4 * 128 * 64; }
    else { base = (bf16_t*)(ws + WS_Z) + ((size_t)b * SEQ + (dv & 63)) * LDZ + (dv < 64 ? FZ1 : I1) + 128 * h + 8 * dkg; cstride = (size_t)64 * LDZ; }
    const float* gcb = GC + ((size_t)(b * 64) * H + h) * DK + 8 * dkg; const size_t gstride = (size_t)H * DK;
    float S[8];
#pragma unroll
    for (int e = 0; e < 8; ++e) S[e] = 0.f;
    for (int c0 = 0; c0 < NCHUNK; c0 += 8) {
        u32x4 kv[8]; f32x4 g0[8], g1[8];
#pragma unroll
        for (int i = 0; i < 8; ++i) { kv[i] = *(const u32x4*)(base + (size_t)(c0 + i) * cstride); g0[i] = *(const f32x4*)(gcb + (size_t)(c0 + i) * gstride); g1[i] = *(const f32x4*)(gcb + (size_t)(c0 + i) * gstride + 4); }
#pragma unroll
        for (int i = 0; i < 8; ++i) {
            S[0] = g0[i][0] * S[0] + bflo(kv[i].x); S[1] = g0[i][1] * S[1] + bfhi(kv[i].x); S[2] = g0[i][2] * S[2] + bflo(kv[i].y); S[3] = g0[i][3] * S[3] + bfhi(kv[i].y);
            S[4] = g1[i][0] * S[4] + bflo(kv[i].z); S[5] = g1[i][1] * S[5] + bfhi(kv[i].z); S[6] = g1[i][2] * S[6] + bflo(kv[i].w); S[7] = g1[i][3] * S[7] + bfhi(kv[i].w);
            u32x4 o; o.x = pk2(S[0], S[1]); o.y = pk2(S[2], S[3]); o.z = pk2(S[4], S[5]); o.w = pk2(S[6], S[7]);
            *(u32x4*)(base + (size_t)(c0 + i) * cstride) = o;
        }
    }
}

template <int L>
__device__ __forceinline__ void p3_wtask(const Args& a, int wt, int lane) {
    constexpr int DK = L ? 128 : 64, H = L ? 8 : 4, KS = DK / 32, LDZ = L ? LDZ1 : LDZ0;
    unsigned char* ws = a.ws;
    bf16_t* Z = (bf16_t*)(ws + WS_Z);
    const int tt = wt & 3, task = wt >> 2, h = task % H; const size_t tok0 = (size_t)(task / H) * 64;
    const int cj = lane & 15, q = lane >> 4;
    const size_t rowo = (tok0 + 16 * tt + cj) * LDZ;
    bf16x8 qf[KS];
#pragma unroll
    for (int ks = 0; ks < KS; ++ks) {
        u32x4 w = *(const u32x4*)(Z + rowo + (L ? Q1 : Q0) + DK * h + 32 * ks + 8 * q);
        if (L == 1) { w.x = pk2(siluf_(bflo(w.x)), siluf_(bfhi(w.x))); w.y = pk2(siluf_(bflo(w.y)), siluf_(bfhi(w.y))); w.z = pk2(siluf_(bflo(w.z)), siluf_(bfhi(w.z))); w.w = pk2(siluf_(bflo(w.w)), siluf_(bfhi(w.w))); }
        qf[ks] = __builtin_bit_cast(bf16x8, w);
    }
    f32x4 acc[8];
#pragma unroll
    for (int dt = 0; dt < 8; ++dt) {
        acc[dt] = (f32x4){0.f, 0.f, 0.f, 0.f};
        const int dv = 16 * dt + cj;
        const bf16_t* srow = (L == 0) ? (const bf16_t*)(ws + WS_KV0) + ((size_t)task * 128 + dv) * 64 : Z + (tok0 + (dv & 63)) * LDZ + (dv < 64 ? FZ1 : I1) + 128 * h;
#pragma unroll
        for (int ks = 0; ks < KS; ++ks) { const bf16x8 sf = *(const bf16x8*)(srow + 32 * ks + 8 * q);
            acc[dt] = __builtin_amdgcn_mfma_f32_16x16x32_bf16(sf, qf[ks], acc[dt], 0, 0, 0); }
    }
    float ss = 0.f;
#pragma unroll
    for (int dt = 0; dt < 8; ++dt) ss += (acc[dt][0] * acc[dt][0] + acc[dt][1] * acc[dt][1]) + (acc[dt][2] * acc[dt][2] + acc[dt][3] * acc[dt][3]);
    ss += __shfl_xor(ss, 16); ss += __shfl_xor(ss, 32);
    const float rstd = 1.0f / sqrtf(ss * (1.0f / 128.0f) + EPS);
    const float* hn = L ? a.in[25] : a.in[14];
#pragma unroll
    for (int dt = 0; dt < 8; ++dt) {
        const int dv0 = 16 * dt + 4 * q;
        const u32x2 gw = *(const u32x2*)(Z + rowo + (L ? G1 : G0) + 128 * h + dv0);
        const f32x4 hv = *(const f32x4*)(hn + dv0);
        const float o0 = acc[dt][0] * rstd * hv[0] * siluf_(bflo(gw.x)), o1 = acc[dt][1] * rstd * hv[1] * siluf_(bfhi(gw.x));
        const float o2 = acc[dt][2] * rstd * hv[2] * siluf_(bflo(gw.y)), o3 = acc[dt][3] * rstd * hv[3] * siluf_(bfhi(gw.y));
        u32x2 o; o.x = pk2(o0, o1); o.y = pk2(o2, o3);
        *(u32x2*)(Z + rowo + (L ? Q1 : V0) + 128 * h + dv0) = o;
    }
}

template <bool FINAL>
__device__ __forceinline__ void lru_task(const Args& a, LAS unsigned char* lds, int task, int wid, int lane) {
    unsigned char* ws = a.ws;
    bf16_t* Z = (bf16_t*)(ws + WS_Z);
    const bf16_t* WAT = (const bf16_t*)(ws + WS_WLRU); const bf16_t* WXT = WAT + 32768;
    float* SUMA = (float*)(ws + WS_SUMA); float* SUMH = (float*)(ws + WS_SUMH);
    const int g = wid, cj = lane & 15, q = lane >> 4, c = task & 63; const size_t tok0 = (size_t)task * 64;
    LAS float* AL = (LAS float*)(lds + wid * 17408); LAS float* UL = AL + 32 * 68;
    float hcar = 0.f, atot = 1.f;
    if (FINAL) {
        const int b = task >> 6;
        for (int cc = 0; cc < c; ++cc) { const size_t o = (size_t)(b * 64 + cc) * 512 + 64 * g + lane; hcar = SUMA[o] * hcar + SUMH[o]; }
    }
#pragma unroll 1
    for (int half = 0; half < 2; ++half) {
#pragma unroll 1
        for (int t2 = 0; t2 < 2; ++t2) {
            const int tt = 2 * half + t2, t = 16 * tt + cj;
            bf16x8 xf[2];
#pragma unroll
            for (int ks = 0; ks < 2; ++ks) {
                const int ci = 64 * g + 32 * ks + 8 * q;
                float xc[8];
                { const f32x4 b0 = *(const f32x4*)(a.in[16] + ci), b1 = *(const f32x4*)(a.in[16] + ci + 4);
                  xc[0] = b0[0]; xc[1] = b0[1]; xc[2] = b0[2]; xc[3] = b0[3]; xc[4] = b1[0]; xc[5] = b1[1]; xc[6] = b1[2]; xc[7] = b1[3]; }
#pragma unroll
                for (int j = 0; j < 4; ++j) {
                    const int tj = t - 3 + j;
                    u32x4 w = (u32x4){0u, 0u, 0u, 0u};
                    if (c > 0 || tj >= 0) w = *(const u32x4*)(Z + (size_t)((long)tok0 + tj) * LDZ0 + XR0 + ci);
                    const f32x4 c0 = *(const f32x4*)(a.in[15] + j * 512 + ci), c1 = *(const f32x4*)(a.in[15] + j * 512 + ci + 4);
                    xc[0] += c0[0] * bflo(w.x); xc[1] += c0[1] * bfhi(w.x); xc[2] += c0[2] * bflo(w.y); xc[3] += c0[3] * bfhi(w.y);
                    xc[4] += c1[0] * bflo(w.z); xc[5] += c1[1] * bfhi(w.z); xc[6] += c1[2] * bflo(w.w); xc[7] += c1[3] * bfhi(w.w);
                }
                u32x4 o; o.x = pk2(xc[0], xc[1]); o.y = pk2(xc[2], xc[3]); o.z = pk2(xc[4], xc[5]); o.w = pk2(xc[6], xc[7]);
                xf[ks] = __builtin_bit_cast(bf16x8, o);
            }
#pragma unroll 1
            for (int jt = 0; jt < 4; ++jt) {
                const int chj = 64 * g + 16 * jt + cj; const float cba = a.in[18][chj], cbx = a.in[20][chj], cls = 8.0f * logsigmoidf_(a.in[21][chj]);
                f32x4 aa = (f32x4){0.f, 0.f, 0.f, 0.f}, ax = aa, ac = aa;
#pragma unroll
                for (int ks = 0; ks < 2; ++ks) {
                    const bf16x8 waf = *(const bf16x8*)(WAT + g * 4096 + (16 * jt + cj) * 64 + 32 * ks + 8 * q);
                    const bf16x8 wxf = *(const bf16x8*)(WXT + g * 4096 + (16 * jt + cj) * 64 + 32 * ks + 8 * q);
                    bf16x8 idf;
#pragma unroll
                    for (int e = 0; e < 8; ++e) idf[e] = (32 * ks + 8 * q + e == 16 * jt + cj) ? (short)0x3F80 : (short)0;
                    aa = __builtin_amdgcn_mfma_f32_16x16x32_bf16(xf[ks], waf, aa, 0, 0, 0);
                    ax = __builtin_amdgcn_mfma_f32_16x16x32_bf16(xf[ks], wxf, ax, 0, 0, 0);
                    ac = __builtin_amdgcn_mfma_f32_16x16x32_bf16(xf[ks], idf, ac, 0, 0, 0);
                }
#pragma unroll
                for (int r = 0; r < 4; ++r) {
                    const float rg = sigmoidf_(aa[r] + cba), ig = sigmoidf_(ax[r] + cbx);
                    const float la = cls * rg; const float av = expf(la);
                    const float uv = sqrtf(fmaxf(1.0f - av * av, 0.f)) * (ig * ac[r]);
                    const int tl = 16 * t2 + 4 * q + r;
                    AL[tl * 68 + 16 * jt + cj] = av; UL[tl * 68 + 16 * jt + cj] = uv;
                }
            }
        }
        asm volatile("s_waitcnt lgkmcnt(0)" ::: "memory"); __builtin_amdgcn_wave_barrier();
#pragma unroll 4
        for (int tl = 0; tl < 32; ++tl) { const float av = AL[tl * 68 + lane], uv = UL[tl * 68 + lane]; hcar = av * hcar + uv; atot *= av; if (FINAL) UL[tl * 68 + lane] = hcar; }
        asm volatile("s_waitcnt lgkmcnt(0)" ::: "memory"); __builtin_amdgcn_wave_barrier();
        if (FINAL) {
#pragma unroll
            for (int it = 0; it < 4; ++it) {
                const int tl = (lane >> 3) + 8 * it, ch8 = (lane & 7) * 8;
                const f32x4 h0 = *(const LAS f32x4*)(UL + tl * 68 + ch8), h1 = *(const LAS f32x4*)(UL + tl * 68 + ch8 + 4);
                bf16_t* p = Z + (tok0 + 32 * half + tl) * LDZ0 + XG0 + 64 * g + ch8;
                const u32x4 xg = *(const u32x4*)p;
                u32x4 o;
                o.x = pk2(h0[0] * gelu_tanh(bflo(xg.x)), h0[1] * gelu_tanh(bfhi(xg.x))); o.y = pk2(h0[2] * gelu_tanh(bflo(xg.y)), h0[3] * gelu_tanh(bfhi(xg.y)));
                o.z = pk2(h1[0] * gelu_tanh(bflo(xg.z)), h1[1] * gelu_tanh(bfhi(xg.z))); o.w = pk2(h1[2] * gelu_tanh(bflo(xg.w)), h1[3] * gelu_tanh(bfhi(xg.w)));
                *(u32x4*)p = o;
            }
            asm volatile("s_waitcnt lgkmcnt(0)" ::: "memory"); __builtin_amdgcn_wave_barrier();
        }
    }
    if (!FINAL) { const size_t o = (size_t)task * 512 + 64 * g + lane; SUMA[o] = atot; SUMH[o] = hcar; }
}

__device__ __forceinline__ void final_phase(const Args& a, int gw, int lane) {
    const float* SS = (const float*)(a.ws + WS_SS0); const float* fn = a.in[10];
    f32x4 gv[4];
#pragma unroll
    for (int j = 0; j < 4; ++j) gv[j] = *((const f32x4*)fn + lane + 64 * j);
    for (int m = gw; m < MTOK; m += 2048) {
        float s = lane < 16 ? SS[(size_t)m * 16 + lane] : 0.f; s = wave_sum(s);
        const float r = 1.0f / sqrtf(s * (1.0f / 1024.0f) + EPS);
        f32x4* xr = (f32x4*)(a.out + (size_t)m * DM) + lane;
#pragma unroll
        for (int j = 0; j < 4; ++j) { f32x4 v = xr[64 * j]; v = v * r * gv[j]; xr[64 * j] = v; }
    }
}

#ifndef PHM
#define PHM 0xFFFF
#endif
__global__ void __launch_bounds__(512, 2) hybrid_fwd(Args args) {
    extern __shared__ __attribute__((aligned(16))) unsigned char lds_raw[];
    LAS unsigned char* lds = (LAS unsigned char*)lds_raw;
    const int bx = blockIdx.x, vcu = (bx % 8) * 32 + bx / 8;
#define TIDS() int tid = threadIdx.x; asm volatile("" : "+v"(tid)); const int lane = tid & 63, wave = __builtin_amdgcn_readfirstlane(tid >> 6); const int gtid = bx * 512 + tid, gw = vcu * 8 + wave; (void)lane; (void)gtid; (void)gw; (void)wave
    unsigned char* ws = args.ws;
    volatile LAS unsigned* MISC = (volatile LAS unsigned*)(lds + MISC_OFF);
    if (threadIdx.x < 32) MISC[threadIdx.x] = 0u;
    __syncthreads();
    XcdBarrier bar = xcd_barrier_post((unsigned*)(ws + WS_CTL) + 4096, MISC + 8);
    cg::grid_group grid = cg::this_grid();
#define GRID_BAR() xcd_barrier(bar)

    bf16_t* XB = (bf16_t*)(ws + WS_XB); bf16_t* Zb = (bf16_t*)(ws + WS_Z);
    float* SS0 = (float*)(ws + WS_SS0); float* SS1 = (float*)(ws + WS_SS1);
    float* X = args.out;

    if (PHM & 1) { TIDS(); pre_phase(args, lds, vcu, wave, lane); }
    __syncthreads();
    grid.sync();

#pragma unroll 1
    for (int l = 0; l < 2; ++l) {
#pragma unroll 1
        for (int j = 0; j < 2; ++j) {
            if (j == 1) {
            }
            if ((PHM & 2) && j == 1) { TIDS(); pconv_phase(args.in[1] + (size_t)l * MTOK * 256, (bf16_t*)(ws + WS_PB), gtid); }
            {
                pg8::Gemm g{XB, (const bf16_t*)(ws + WS_WUP) + (size_t)(2 * l + j) * 5632 * DM, MTOK, 5632, DM, DM};
                pg8::StaticOrder S; S.init(MTOK, 5632, 256, bx);
                pg8::EpiUp E{Zb, SS0};
                if (PHM & 4) pg8::gemm_phase<pg8::EpiUp>(lds, g, S, E);
            }
            GRID_BAR();
            {
                pg8::Gemm g{Zb, (const bf16_t*)(ws + WS_WDN) + (size_t)(2 * l + j) * DM * FF, MTOK, DM, FF, FF};
                pg8::StaticOrder S; S.init(MTOK, DM, 256, bx);
                pg8::EpiRes E{(l == 0 && j == 0) ? args.in[0] : (const float*)X, X, XB, SS1, 0.5f};
                if (PHM & 8) pg8::gemm_phase<pg8::EpiRes>(lds, g, S, E);
            }
            GRID_BAR();
            if (j == 0) {
                {
                    const int N = l ? 4096 : 2816;
                    pg8::Gemm g{XB, (const bf16_t*)(ws + (l ? WS_WIN1 : WS_WIN0)), MTOK, N, DM, DM};
                    pg8::StaticOrder S; S.init(MTOK, N, 256, bx);
                    pg8::EpiZ E{Zb, N, SS1};
                    if (PHM & 16) pg8::gemm_phase<pg8::EpiZ>(lds, g, S, E);
                }
                GRID_BAR();
                if (l == 0) {
                    { TIDS();
                    for (int t = bx; t < 2048 + 512; t += 256) { if (t < 2048) { if (PHM & 32) p1_task<0>(args, lds, t, tid); } else { if (PHM & 64) lru_task<false>(args, lds, t - 2048, wave, lane); __syncthreads(); } } }
                    GRID_BAR();
                    if (PHM & 128) { TIDS(); p2_phase<0>(args, gtid); }
                    if (PHM & 256) { TIDS(); for (int t = bx; t < 512; t += 256) lru_task<true>(args, lds, t, wave, lane); }
                    GRID_BAR();
                    if (PHM & 512) { TIDS(); for (int wt = gw; wt < 8192; wt += 2048) p3_wtask<0>(args, wt, lane); }
                } else {
                    if (PHM & 32) { TIDS(); for (int t = bx; t < 4096; t += 256) p1_task<1>(args, lds, t, tid); }
                    GRID_BAR();
                    if (PHM & 128) { TIDS(); p2_phase<1>(args, gtid); }
                    GRID_BAR();
                    if (PHM & 512) { TIDS(); for (int wt = gw; wt < 16384; wt += 2048) p3_wtask<1>(args, wt, lane); }
                }
                GRID_BAR();
                {
                    pg8::Gemm g{Zb + (l ? 0 : V0), (const bf16_t*)(ws + WS_WOUT) + (size_t)l * DM * DM, MTOK, DM, DM, l ? LDZ1 : LDZ0};
                    pg8::StaticOrder S; S.init(MTOK, DM, 256, bx);
                    pg8::EpiRes E{X, X, XB, SS0, 1.0f};
                    if (PHM & 1024) pg8::gemm_phase<pg8::EpiRes>(lds, g, S, E);
                }
                GRID_BAR();
            }
        }
        {
            {
                pg8::Gemm g{(const bf16_t*)(ws + WS_PB), (const bf16_t*)(ws + WS_WPROJ) + (size_t)l * DM * 256, MTOK, DM, 256, 256};
                pg8::StaticOrder S; S.init(MTOK, DM, 256, bx);
                pg8::EpiPP E{(float*)(ws + WS_Z)};
                if (PHM & 2048) pg8::gemm_phase<pg8::EpiPP>(lds, g, S, E);
            }
            {
                pg8::Gemm g{XB, (const bf16_t*)(ws + WS_WGATE) + (size_t)l * DM * DM, MTOK, DM, DM, DM};
                pg8::StaticOrder S; S.init(MTOK, DM, 256, bx);
                pg8::EpiPle E{X, XB, (const float*)(ws + WS_Z), SS1, SS0};
                if (PHM & 4096) pg8::gemm_phase<pg8::EpiPle>(lds, g, S, E);
            }
            GRID_BAR();
        }
    }
    if (PHM & 8192) { TIDS(); final_phase(args, gw, lane); }
}

extern "C" void kernel_launch(void* const* d_in, const int* in_sizes, int n_in, void* d_out, int out_size, void* d_ws, size_t ws_size, hipStream_t stream) {
    static int ready = 0;
    if (ready == 0) {
        if (n_in != 27 || out_size != MTOK * DM || ws_size < WS_END) { fprintf(stderr, "kernel_launch: unexpected shapes (n_in %d out %d ws %zu need %zu)\n", n_in, out_size, ws_size, (size_t)WS_END); ready = -1; return; }
        if (hipFuncSetAttribute((const void*)hybrid_fwd, hipFuncAttributeMaxDynamicSharedMemorySize, LDS_BYTES) != hipSuccess) { fprintf(stderr, "kernel_launch: hipFuncSetAttribute failed\n"); ready = -1; return; }
        (void)hipGetLastError();
        ready = 1;
    }
    if (ready < 0) return;
    (void)hipMemsetAsync((char*)d_ws + WS_CTL, 0, 1 * MiB, stream);
    Args a{};
    for (int i = 0; i < 27; ++i) a.in[i] = (const float*)d_in[i];
    a.out = (float*)d_out; a.ws = (unsigned char*)d_ws;
    void* kargs[] = {&a};
    hipError_t e = hipLaunchCooperativeKernel((const void*)hybrid_fwd, dim3(256), dim3(512), kargs, LDS_BYTES, stream);
    if (e != hipSuccess) fprintf(stderr, "kernel_launch: cooperative launch failed: %s\n", hipGetErrorString(e));
}
```

```cpp
#include <hip/hip_runtime.h>
#include <hip/hip_cooperative_groups.h>
#include <cstdio>
#include <cstdint>
namespace cg = cooperative_groups;

#define LAS __attribute__((address_space(3)))
typedef unsigned short bf16_t;
typedef short bf16x8 __attribute__((ext_vector_type(8)));
typedef float f32x4 __attribute__((ext_vector_type(4)));
typedef float f32x2 __attribute__((ext_vector_type(2)));
typedef unsigned u32x4 __attribute__((ext_vector_type(4)));
typedef unsigned u32x2 __attribute__((ext_vector_type(2)));

constexpr int MTOK = 32768, DM = 1024, FF = 2816, SEQ = 4096, NCHUNK = 64;
constexpr float EPS = 1e-6f;
constexpr int LDZ0 = 2848, Q0 = 0, K0 = 256, V0 = 512, XG0 = 1024, XR0 = 1536, G0 = 2048, GP0 = 2560;
constexpr int LDZ1 = 4160, Q1 = 0, FZ1 = 1024, I1 = 2048, G1 = 3072;

constexpr size_t MiB = 1u << 20;
constexpr size_t WS_CTL = 0;
constexpr size_t WS_WUP = 1 * MiB;
constexpr size_t WS_WDN = 45 * MiB;
constexpr size_t WS_WIN0 = 67 * MiB;
constexpr size_t WS_WIN1 = 73 * MiB;
constexpr size_t WS_WOUT = 81 * MiB;
constexpr size_t WS_WGATE = 85 * MiB;
constexpr size_t WS_WPROJ = 89 * MiB;
constexpr size_t WS_WLRU = 90 * MiB;
constexpr size_t WS_SS0 = 91 * MiB;
constexpr size_t WS_SS1 = 93 * MiB;
constexpr size_t WS_GC = 95 * MiB;
constexpr size_t WS_SUMA = 97 * MiB;
constexpr size_t WS_SUMH = 98 * MiB;
constexpr size_t WS_XB = 100 * MiB;
constexpr size_t WS_Z = 164 * MiB;
constexpr size_t WS_KV0 = WS_Z + 180 * MiB;
constexpr size_t WS_PB = WS_Z + 212 * MiB;
constexpr size_t WS_XB2 = WS_Z + 260 * MiB;
constexpr size_t WS_END = WS_XB2 + 64 * MiB;

constexpr int LDS_BYTES = 147456;
constexpr int MISC_OFF = 143360;

__device__ __forceinline__ unsigned f2bf(float f) { unsigned u = __builtin_bit_cast(unsigned, f); return (u + 0x7fffu + ((u >> 16) & 1u)) >> 16; }
typedef __bf16 bf16x2_t __attribute__((ext_vector_type(2)));
__device__ __forceinline__ unsigned pk2(float lo, float hi) { const f32x2 v = {lo, hi}; return __builtin_bit_cast(unsigned, __builtin_convertvector(v, bf16x2_t)); }
__device__ __forceinline__ float bflo(unsigned w) { return __builtin_bit_cast(float, w << 16); }
__device__ __forceinline__ float bfhi(unsigned w) { return __builtin_bit_cast(float, w & 0xffff0000u); }
__device__ __forceinline__ float bf2f(bf16_t b) { return __builtin_bit_cast(float, ((unsigned)b) << 16); }
__device__ __forceinline__ unsigned cvt_pk_bf16(float lo, float hi) { return pk2(lo, hi); }
__device__ __forceinline__ float fast_sigmoid(float x) { return __builtin_amdgcn_rcpf(1.0f + __builtin_amdgcn_exp2f(-1.44269504089f * x)); }
__device__ __forceinline__ float fast_silu(float x) { return x * fast_sigmoid(x); }
__device__ __forceinline__ float fexp(float x) { return __builtin_amdgcn_exp2f(1.44269504089f * x); }
__device__ __forceinline__ float flog(float x) { return 0.69314718056f * __builtin_amdgcn_logf(x); }
__device__ __forceinline__ float fast_gelu_tanh(float x) { const float y = 0.7978845608028654f * (x + 0.044715f * x * x * x); return x * fast_sigmoid(2.0f * y); }
__device__ __forceinline__ float sigmoidf_(float x) { return 1.0f / (1.0f + expf(-x)); }
__device__ __forceinline__ float siluf_(float x) { return x / (1.0f + expf(-x)); }
__device__ __forceinline__ float logsigmoidf_(float x) { return fminf(x, 0.f) - log1pf(expf(-fabsf(x))); }
__device__ __forceinline__ float gelu_tanh(float x) { const float y = 0.7978845608028654f * (x + 0.044715f * x * x * x); const float t = 1.0f - 2.0f / (expf(2.0f * y) + 1.0f); return 0.5f * x * (1.0f + t); }

namespace pg8 {
constexpr int BM = 256, BK = 64, HALF = 128, HTB = HALF * BK * 2, STAGE_BYTES = 8 * HTB, NXCD = 8, WGM = 8;
__host__ __device__ __forceinline__ int lds_byte(int r, int c) { const int st = (r >> 4) * 2 + (c >> 5), rr = r & 15, cc = c & 31, ob = rr * 64 + cc * 2; return st * 1024 + (ob ^ (((ob >> 9) & 1) << 5)); }
__host__ __device__ __forceinline__ void stage_rc(int b, int& R, int& C) { const int st = b / 1024, sb = b % 1024, swz = sb ^ (((sb >> 9) & 1) << 5); R = (st >> 1) * 16 + swz / 64; C = (st & 1) * 32 + (swz % 64) / 2; }
__host__ __device__ __forceinline__ int perm32(int rho) { const int n = rho >> 4, i = rho & 15; return 8 * (i >> 2) + 4 * n + (i & 3); }
struct Unit { int pm, pn; };
struct Gemm { const bf16_t* A; const bf16_t* Bt; int M, N, K, lda; };
struct StaticOrder {
    int nM, nN, nwg, G, c;
    __device__ void init(int M, int N, int G_, int c_) { nM = M / BM; nN = N / BM; nwg = nM * nN; G = G_; c = c_; }
    __device__ bool next(int i, Unit& u) const {
        const long L = (long)i * G + c; if (L >= nwg) return false;
        int wgid = (int)L; { const int q = nwg / NXCD, r = nwg % NXCD, xcd = wgid % NXCD, off = wgid / NXCD; wgid = (xcd < r ? xcd * (q + 1) : r * (q + 1) + (xcd - r) * q) + off; }
        const int nig = WGM * nN, gid = wgid / nig, fm = gid * WGM, gsz = (nM - fm) < WGM ? (nM - fm) : WGM;
        u.pm = fm + ((wgid % nig) % gsz); u.pn = (wgid % nig) / gsz; return true;
    }
};

__device__ __forceinline__ float row_rstd(const float* SS, int row, int fq) {
    const f32x4 p = *(const f32x4*)(SS + (size_t)row * 16 + 4 * fq);
    float s = (p[0] + p[1]) + (p[2] + p[3]);
    s += __shfl_xor(s, 16); s += __shfl_xor(s, 32);
    return __builtin_amdgcn_rsqf(s * (1.0f / 1024.0f) + EPS);
}
struct EpiUp {
    bf16_t* U; const float* SS;
    static __device__ __forceinline__ f32x2 silu_mul2(f32x2 a, f32x2 g, float nr, float r2) {
        const f32x2 t = a * nr;
        f32x2 e; e.x = __builtin_amdgcn_exp2f(t.x); e.y = __builtin_amdgcn_exp2f(t.y);
        const f32x2 d = e + 1.0f;
        f32x2 s; s.x = __builtin_amdgcn_rcpf(d.x); s.y = __builtin_amdgcn_rcpf(d.y);
        return ((a * g) * r2) * s;
    }
    __device__ __forceinline__ void operator()(f32x4 (&acc)[2][2][4][2], const Unit& u, int wr, int wc, int fr, int fq) const {
        const int row0 = u.pm * BM + wr * 64 + fr, col0 = u.pn * 128 + wc * 32 + 8 * fq;
#pragma unroll
        for (int ai = 0; ai < 2; ++ai)
#pragma unroll
            for (int m = 0; m < 4; ++m) {
                const int row = row0 + ai * HALF + m * 16; const float r = row_rstd(SS, row, fq);
                const float nr = -1.44269504089f * r, r2 = r * r;
                const f32x4 a0 = acc[ai][0][m][0], a1 = acc[ai][0][m][1], g0 = acc[ai][1][m][0], g1 = acc[ai][1][m][1];
                const f32x2 o0 = silu_mul2((f32x2){a0[0], a0[1]}, (f32x2){g0[0], g0[1]}, nr, r2), o1 = silu_mul2((f32x2){a0[2], a0[3]}, (f32x2){g0[2], g0[3]}, nr, r2);
                const f32x2 o2 = silu_mul2((f32x2){a1[0], a1[1]}, (f32x2){g1[0], g1[1]}, nr, r2), o3 = silu_mul2((f32x2){a1[2], a1[3]}, (f32x2){g1[2], g1[3]}, nr, r2);
                u32x4 w; w.x = cvt_pk_bf16(o0.x, o0.y); w.y = cvt_pk_bf16(o1.x, o1.y); w.z = cvt_pk_bf16(o2.x, o2.y); w.w = cvt_pk_bf16(o3.x, o3.y);
                *(u32x4*)(U + (size_t)row * FF + col0) = w;
                asm volatile("" ::: "memory");
            }
    }
};
struct EpiZ {
    bf16_t* Z; int ldz; const float* SS;
    __device__ __forceinline__ void operator()(f32x4 (&acc)[2][2][4][2], const Unit& u, int wr, int wc, int fr, int fq) const {
        const int row0 = u.pm * BM + wr * 64 + fr, col0 = u.pn * BM + wc * 32 + 8 * fq;
#pragma unroll
        for (int ai = 0; ai < 2; ++ai)
#pragma unroll
            for (int m = 0; m < 4; ++m) {
                const int row = row0 + ai * HALF + m * 16; const float r = row_rstd(SS, row, fq);
#pragma unroll
                for (int bj = 0; bj < 2; ++bj) {
                    const f32x4 v0 = acc[ai][bj][m][0] * r, v1 = acc[ai][bj][m][1] * r;
                    u32x4 w; w.x = cvt_pk_bf16(v0[0], v0[1]); w.y = cvt_pk_bf16(v0[2], v0[3]); w.z = cvt_pk_bf16(v1[0], v1[1]); w.w = cvt_pk_bf16(v1[2], v1[3]);
                    *(u32x4*)(Z + (size_t)row * ldz + col0 + bj * HALF) = w;
                }
                asm volatile("" ::: "memory");
            }
    }
};
struct EpiRes {
    const float* basef; const bf16_t* baseb; bf16_t* XB; float* SSo; float alpha;
    __device__ __forceinline__ void operator()(f32x4 (&acc)[2][2][4][2], const Unit& u, int wr, int wc, int fr, int fq) const {
        const int row0 = u.pm * BM + wr * 64 + fr, col0 = u.pn * BM + wc * 32 + 8 * fq;
#pragma unroll
        for (int ai = 0; ai < 2; ++ai)
#pragma unroll
            for (int m = 0; m < 4; ++m) {
                const int row = row0 + ai * HALF + m * 16; float ssq = 0.f;
#pragma unroll
                for (int bj = 0; bj < 2; ++bj) {
                    const size_t off = (size_t)row * DM + col0 + bj * HALF;
                    f32x4 b0, b1;
                    if (basef) { b0 = *(const f32x4*)(basef + off); b1 = *(const f32x4*)(basef + off + 4); }
                    else { const u32x4 bw = *(const u32x4*)(baseb + off); b0 = (f32x4){bflo(bw.x), bfhi(bw.x), bflo(bw.y), bfhi(bw.y)}; b1 = (f32x4){bflo(bw.z), bfhi(bw.z), bflo(bw.w), bfhi(bw.w)}; }
                    const f32x4 v0 = b0 + acc[ai][bj][m][0] * alpha, v1 = b1 + acc[ai][bj][m][1] * alpha;
                    u32x4 w; w.x = cvt_pk_bf16(v0[0], v0[1]); w.y = cvt_pk_bf16(v0[2], v0[3]); w.z = cvt_pk_bf16(v1[0], v1[1]); w.w = cvt_pk_bf16(v1[2], v1[3]);
                    *(u32x4*)(XB + off) = w;
                    ssq += (v0[0] * v0[0] + v0[1] * v0[1]) + (v0[2] * v0[2] + v0[3] * v0[3]) + (v1[0] * v1[0] + v1[1] * v1[1]) + (v1[2] * v1[2] + v1[3] * v1[3]);
                }
                ssq += __shfl_xor(ssq, 16); ssq += __shfl_xor(ssq, 32);
                if (fq == 0) SSo[(size_t)row * 16 + u.pn * 4 + wc] = ssq;
                asm volatile("" ::: "memory");
            }
    }
};
struct EpiPP {
    bf16_t* PP;
    __device__ __forceinline__ void operator()(f32x4 (&acc)[2][2][4][2], const Unit& u, int wr, int wc, int fr, int fq) const {
        const int row0 = u.pm * BM + wr * 64 + fr, col0 = u.pn * BM + wc * 32 + 8 * fq;
#pragma unroll
        for (int ai = 0; ai < 2; ++ai)
#pragma unroll
            for (int m = 0; m < 4; ++m) {
                const int row = row0 + ai * HALF + m * 16;
#pragma unroll
                for (int bj = 0; bj < 2; ++bj) { const size_t off = (size_t)row * DM + col0 + bj * HALF; const f32x4 v0 = acc[ai][bj][m][0], v1 = acc[ai][bj][m][1];
                    u32x4 w; w.x = cvt_pk_bf16(v0[0], v0[1]); w.y = cvt_pk_bf16(v0[2], v0[3]); w.z = cvt_pk_bf16(v1[0], v1[1]); w.w = cvt_pk_bf16(v1[2], v1[3]);
                    *(u32x4*)(PP + off) = w; }
                asm volatile("" ::: "memory");
            }
    }
};
__device__ __forceinline__ f32x2 gate_fma2(f32x2 a, f32x2 p, f32x2 b, float nr) {
    const f32x2 t = a * nr;
    f32x2 e; e.x = __builtin_amdgcn_exp2f(t.x); e.y = __builtin_amdgcn_exp2f(t.y);
    const f32x2 d = e + 1.0f;
    f32x2 sg; sg.x = __builtin_amdgcn_rcpf(d.x); sg.y = __builtin_amdgcn_rcpf(d.y);
    return sg * p + b;
}
struct EpiPle {
    const bf16_t* XBi; bf16_t* XBo; float* Xf; const bf16_t* PP; const float* SSi; float* SSo;
    __device__ __forceinline__ void operator()(f32x4 (&acc)[2][2][4][2], const Unit& u, int wr, int wc, int fr, int fq) const {
        const int row0 = u.pm * BM + wr * 64 + fr, col0 = u.pn * BM + wc * 32 + 8 * fq;
#pragma unroll
        for (int ai = 0; ai < 2; ++ai)
#pragma unroll
            for (int m = 0; m < 4; ++m) {
                const int row = row0 + ai * HALF + m * 16; const float r = row_rstd(SSi, row, fq); float ssq = 0.f;
#pragma unroll
                for (int bj = 0; bj < 2; ++bj) {
                    const size_t off = (size_t)row * DM + col0 + bj * HALF;
                    const u32x4 bw = *(const u32x4*)(XBi + off);
                    const f32x4 b0 = (f32x4){bflo(bw.x), bfhi(bw.x), bflo(bw.y), bfhi(bw.y)}, b1 = (f32x4){bflo(bw.z), bfhi(bw.z), bflo(bw.w), bfhi(bw.w)};
                    const u32x4 pw = *(const u32x4*)(PP + off);
                    const f32x4 p0 = (f32x4){bflo(pw.x), bfhi(pw.x), bflo(pw.y), bfhi(pw.y)}, p1 = (f32x4){bflo(pw.z), bfhi(pw.z), bflo(pw.w), bfhi(pw.w)};
                    f32x4 v0, v1;
                    { const float nr = -1.44269504089f * r; const f32x4 A0 = acc[ai][bj][m][0], A1 = acc[ai][bj][m][1];
                      const f32x2 q0 = gate_fma2((f32x2){A0[0], A0[1]}, (f32x2){p0[0], p0[1]}, (f32x2){b0[0], b0[1]}, nr), q1 = gate_fma2((f32x2){A0[2], A0[3]}, (f32x2){p0[2], p0[3]}, (f32x2){b0[2], b0[3]}, nr);
                      const f32x2 q2 = gate_fma2((f32x2){A1[0], A1[1]}, (f32x2){p1[0], p1[1]}, (f32x2){b1[0], b1[1]}, nr), q3 = gate_fma2((f32x2){A1[2], A1[3]}, (f32x2){p1[2], p1[3]}, (f32x2){b1[2], b1[3]}, nr);
                      v0 = (f32x4){q0.x, q0.y, q1.x, q1.y}; v1 = (f32x4){q2.x, q2.y, q3.x, q3.y}; }
                    if (Xf) { *(f32x4*)(Xf + off) = v0; *(f32x4*)(Xf + off + 4) = v1; }
                    u32x4 w; w.x = cvt_pk_bf16(v0[0], v0[1]); w.y = cvt_pk_bf16(v0[2], v0[3]); w.z = cvt_pk_bf16(v1[0], v1[1]); w.w = cvt_pk_bf16(v1[2], v1[3]);
                    if (XBo) *(u32x4*)(XBo + off) = w;
                    ssq += (v0[0] * v0[0] + v0[1] * v0[1]) + (v0[2] * v0[2] + v0[3] * v0[3]) + (v1[0] * v1[0] + v1[1] * v1[1]) + (v1[2] * v1[2] + v1[3] * v1[3]);
                }
                ssq += __shfl_xor(ssq, 16); ssq += __shfl_xor(ssq, 32);
                if (fq == 0) SSo[(size_t)row * 16 + u.pn * 4 + wc] = ssq;
                asm volatile("" ::: "memory");
            }
    }
};
struct EpiPleFinal {
    float* X; const bf16_t* XBi; const bf16_t* PP; const float* SSi; float* SSo; const float* gain; unsigned* cnt; unsigned* tmo;
    __device__ __forceinline__ void operator()(f32x4 (&acc)[2][2][4][2], const Unit& u, int wr, int wc, int fr, int fq) const {
        const int row0 = u.pm * BM + wr * 64 + fr, col0 = u.pn * BM + wc * 32 + 8 * fq;
#pragma unroll
        for (int ai = 0; ai < 2; ++ai)
#pragma unroll
            for (int m = 0; m < 4; ++m) {
                const int row = row0 + ai * HALF + m * 16; const float r = row_rstd(SSi, row, fq); float ssq = 0.f;
#pragma unroll
                for (int bj = 0; bj < 2; ++bj) {
                    const size_t off = (size_t)row * DM + col0 + bj * HALF;
                    const u32x4 bw = *(const u32x4*)(XBi + off);
                    const f32x4 b0 = (f32x4){bflo(bw.x), bfhi(bw.x), bflo(bw.y), bfhi(bw.y)}, b1 = (f32x4){bflo(bw.z), bfhi(bw.z), bflo(bw.w), bfhi(bw.w)};
                    const u32x4 pw = *(const u32x4*)(PP + off);
                    const f32x4 p0 = (f32x4){bflo(pw.x), bfhi(pw.x), bflo(pw.y), bfhi(pw.y)}, p1 = (f32x4){bflo(pw.z), bfhi(pw.z), bflo(pw.w), bfhi(pw.w)};
                    f32x4 v0, v1;
                    { const float nr = -1.44269504089f * r; const f32x4 A0 = acc[ai][bj][m][0], A1 = acc[ai][bj][m][1];
                      const f32x2 q0 = gate_fma2((f32x2){A0[0], A0[1]}, (f32x2){p0[0], p0[1]}, (f32x2){b0[0], b0[1]}, nr), q1 = gate_fma2((f32x2){A0[2], A0[3]}, (f32x2){p0[2], p0[3]}, (f32x2){b0[2], b0[3]}, nr);
                      const f32x2 q2 = gate_fma2((f32x2){A1[0], A1[1]}, (f32x2){p1[0], p1[1]}, (f32x2){b1[0], b1[1]}, nr), q3 = gate_fma2((f32x2){A1[2], A1[3]}, (f32x2){p1[2], p1[3]}, (f32x2){b1[2], b1[3]}, nr);
                      v0 = (f32x4){q0.x, q0.y, q1.x, q1.y}; v1 = (f32x4){q2.x, q2.y, q3.x, q3.y}; }
                    acc[ai][bj][m][0] = v0; acc[ai][bj][m][1] = v1;
                    ssq += (v0[0] * v0[0] + v0[1] * v0[1]) + (v0[2] * v0[2] + v0[3] * v0[3]) + (v1[0] * v1[0] + v1[1] * v1[1]) + (v1[2] * v1[2] + v1[3] * v1[3]);
                }
                ssq += __shfl_xor(ssq, 16); ssq += __shfl_xor(ssq, 32);
                if (fq == 0) __hip_atomic_store(SSo + (size_t)row * 16 + u.pn * 4 + wc, ssq, __ATOMIC_RELAXED, __HIP_MEMORY_SCOPE_AGENT);
                asm volatile("" ::: "memory");
            }
        asm volatile("s_waitcnt vmcnt(0)" ::: "memory");
        unsigned* c = cnt + 64 * u.pm;
        if ((threadIdx.x & 63) == 0) __hip_atomic_fetch_add(c, 1u, __ATOMIC_RELAXED, __HIP_MEMORY_SCOPE_AGENT);
        {
            unsigned sp = 0;
            while ((unsigned)__builtin_amdgcn_readfirstlane(__hip_atomic_load(c, __ATOMIC_RELAXED, __HIP_MEMORY_SCOPE_AGENT)) < 32u) {
                __builtin_amdgcn_s_sleep(2);
                if (++sp > (1u << 22)) { if ((threadIdx.x & 63) == 0) __hip_atomic_store(tmo, 1u, __ATOMIC_RELAXED, __HIP_MEMORY_SCOPE_AGENT); break; }
            }
        }
#pragma unroll
        for (int ai = 0; ai < 2; ++ai)
#pragma unroll
            for (int m = 0; m < 4; ++m) {
                const int row = row0 + ai * HALF + m * 16;
                const float* sp = SSo + (size_t)row * 16 + 4 * fq;
                float s = (__hip_atomic_load(sp, __ATOMIC_RELAXED, __HIP_MEMORY_SCOPE_AGENT) + __hip_atomic_load(sp + 1, __ATOMIC_RELAXED, __HIP_MEMORY_SCOPE_AGENT))
                        + (__hip_atomic_load(sp + 2, __ATOMIC_RELAXED, __HIP_MEMORY_SCOPE_AGENT) + __hip_atomic_load(sp + 3, __ATOMIC_RELAXED, __HIP_MEMORY_SCOPE_AGENT));
                s += __shfl_xor(s, 16); s += __shfl_xor(s, 32);
                const float rs = __builtin_amdgcn_rsqf(s * (1.0f / 1024.0f) + EPS);
#pragma unroll
                for (int bj = 0; bj < 2; ++bj) {
                    const size_t off = (size_t)row * DM + col0 + bj * HALF;
                    const f32x4 g0 = *(const f32x4*)(gain + col0 + bj * HALF), g1 = *(const f32x4*)(gain + col0 + bj * HALF + 4);
                    *(f32x4*)(X + off) = acc[ai][bj][m][0] * rs * g0; *(f32x4*)(X + off + 4) = acc[ai][bj][m][1] * rs * g1;
                }
                asm volatile("" ::: "memory");
            }
    }
};
struct EpiDry {
    float* sink;
    __device__ __forceinline__ void operator()(f32x4 (&acc)[2][2][4][2], const Unit& u, int wr, int wc, int fr, int fq) const {
        float s = 0.f;
#pragma unroll
        for (int ai = 0; ai < 2; ++ai)
#pragma unroll
            for (int bj = 0; bj < 2; ++bj)
#pragma unroll
                for (int m = 0; m < 4; ++m)
#pragma unroll
                    for (int n = 0; n < 2; ++n) s += (acc[ai][bj][m][n][0] + acc[ai][bj][m][n][1]) + (acc[ai][bj][m][n][2] + acc[ai][bj][m][n][3]);
        if (s == 123456.789f) sink[u.pm + wr + wc + fr + fq] = s;
    }
};
template <class Epi, int MODE = 0>
__device__ __forceinline__ void gemm_phase(LAS unsigned char* lds, const Gemm g, const StaticOrder& S, const Epi& E) {
    int tid = threadIdx.x; asm volatile("" : "+v"(tid));
    const int wid = __builtin_amdgcn_readfirstlane(tid >> 6), lane = tid & 63, wr = wid >> 2, wc = wid & 3, fr = lane & 15, fq = lane >> 4;
    const int K = g.K, nt = K / BK, lda = g.lda;
    unsigned voffA[2], voffB[2];
#pragma unroll
    for (int i = 0; i < 2; ++i) { int R, C; stage_rc(tid * 16 + i * 8192, R, C); const int Rb = (R & ~31) + perm32(R & 31);
        voffA[i] = (unsigned)(R * lda + C) * 2u; voffB[i] = (unsigned)(Rb * K + C) * 2u; }
    const size_t kstep = (size_t)(BK * 2);
    const size_t hA = (size_t)HALF * lda * 2, hB = (size_t)HALF * K * 2;
    const size_t tA = 2 * hA, tB = 2 * hB;
    const unsigned ldsw = (unsigned)wid * 1024u;
    const int aoff = lds_byte(wr * 64 + fr, fq * 8), boff = lds_byte(wc * 32 + fr, fq * 8);
#define PG8_SA(b, h) (((b) * 2 + (h)) * HTB)
#define PG8_SB(b, h) ((4 + (b) * 2 + (h)) * HTB)
#define PG8_STAGE(bufoff, gbase, voff) do { if (MODE != 1) _Pragma("unroll") for (int _i = 0; _i < 2; ++_i) \
        __builtin_amdgcn_global_load_lds((const unsigned*)((const char*)(gbase) + (voff)[_i]), (LAS unsigned*)(lds + (bufoff) + ldsw + _i * 8192), 16, 0, 0); } while (0)
#define PG8_LDA(dst, b, h) do { _Pragma("unroll") for (int m = 0; m < 4; ++m) _Pragma("unroll") for (int k = 0; k < 2; ++k) dst[m][k] = *(const LAS bf16x8*)(lds + PG8_SA(b, h) + aoff + m * 2048 + k * 1024); } while (0)
#define PG8_LDB(dst, b, h) do { _Pragma("unroll") for (int n = 0; n < 2; ++n) _Pragma("unroll") for (int k = 0; k < 2; ++k) dst[n][k] = *(const LAS bf16x8*)(lds + PG8_SB(b, h) + boff + n * 2048 + k * 1024); } while (0)
#define PG8_MMA(ai, bj, At, Bt) do { __builtin_amdgcn_s_setprio(1); if (MODE == 2) { asm volatile("" :: "v"(At[0][0]), "v"(At[1][0]), "v"(At[2][0]), "v"(At[3][0]), "v"(At[0][1]), "v"(At[1][1]), "v"(At[2][1]), "v"(At[3][1]), "v"(Bt[0][0]), "v"(Bt[1][0]), "v"(Bt[0][1]), "v"(Bt[1][1])); } else _Pragma("unroll") for (int m = 0; m < 4; ++m) _Pragma("unroll") for (int n = 0; n < 2; ++n) _Pragma("unroll") for (int k = 0; k < 2; ++k) \
        acc[ai][bj][m][n] = __builtin_amdgcn_mfma_f32_16x16x32_bf16(Bt[n][k], At[m][k], acc[ai][bj][m][n], 0, 0, 0); __builtin_amdgcn_s_setprio(0); } while (0)
#define PG8_WAIT_V(n) asm volatile("s_waitcnt vmcnt(" #n ")" ::: "memory")
#define PG8_WAIT_L(n) asm volatile("s_waitcnt lgkmcnt(" #n ")" ::: "memory")
#define PG8_BAR __builtin_amdgcn_s_barrier()
#define PG8_SCHED __builtin_amdgcn_sched_barrier(0)
    Unit cur, nxt; int ui = 0;
    if (!S.next(0, cur)) return;
    f32x4 acc[2][2][4][2];
#pragma unroll
    for (int a = 0; a < 2; ++a)
#pragma unroll
        for (int b = 0; b < 2; ++b)
#pragma unroll
            for (int m = 0; m < 4; ++m)
#pragma unroll
                for (int n = 0; n < 2; ++n) acc[a][b][m][n] = (f32x4){0.f, 0.f, 0.f, 0.f};
    bf16x8 At[4][2], B0[2][2], B1[2][2];
    const char* cA = (const char*)g.A + (size_t)cur.pm * tA; const char* cB = (const char*)g.Bt + (size_t)cur.pn * tB;
    PG8_STAGE(PG8_SB(0, 0), cB, voffB); PG8_STAGE(PG8_SB(0, 1), cB + hB, voffB); PG8_STAGE(PG8_SA(0, 0), cA, voffA); PG8_STAGE(PG8_SA(0, 1), cA + hA, voffA);
    if (wr == 1) PG8_BAR;
    PG8_WAIT_V(2); PG8_BAR;
    PG8_STAGE(PG8_SB(1, 0), cB + kstep, voffB); PG8_STAGE(PG8_SA(1, 0), cA + kstep, voffA); PG8_STAGE(PG8_SB(1, 1), cB + hB + kstep, voffB);
    PG8_WAIT_V(6); PG8_BAR;
    for (;;) {
        const bool has_next = S.next(ui + 1, nxt);
        const char* nA = has_next ? (const char*)g.A + (size_t)nxt.pm * tA : cA; const char* nB = has_next ? (const char*)g.Bt + (size_t)nxt.pn * tB : cB;
#pragma unroll 1
        for (int t = 0; t < nt; t += 2) {
            const bool last = (t == nt - 2);
            const char* a1 = cA + (size_t)(t + 1) * kstep;
            const char* a2 = last ? nA : cA + (size_t)(t + 2) * kstep; const char* b2 = last ? nB : cB + (size_t)(t + 2) * kstep;
            const char* a3 = a2 + kstep; const char* b3 = b2 + kstep;
            PG8_LDB(B0, 0, 0); PG8_LDB(B1, 0, 1); PG8_SCHED; PG8_LDA(At, 0, 0); PG8_STAGE(PG8_SA(1, 1), a1 + hA, voffA);
            PG8_WAIT_V(8); PG8_WAIT_L(0); PG8_BAR; PG8_MMA(0, 0, At, B0); PG8_MMA(0, 1, At, B1); PG8_BAR; PG8_SCHED;
            PG8_LDA(At, 0, 1); PG8_STAGE(PG8_SB(0, 0), b2, voffB); PG8_STAGE(PG8_SB(0, 1), b2 + hB, voffB); PG8_STAGE(PG8_SA(0, 0), a2, voffA);
            PG8_WAIT_V(8); PG8_WAIT_L(0); PG8_BAR; PG8_MMA(1, 0, At, B0); PG8_MMA(1, 1, At, B1); PG8_BAR; PG8_SCHED;
            PG8_LDB(B0, 1, 0); PG8_LDB(B1, 1, 1); PG8_SCHED; PG8_LDA(At, 1, 0); PG8_STAGE(PG8_SA(0, 1), a2 + hA, voffA);
            PG8_WAIT_V(8); PG8_WAIT_L(0); PG8_BAR; PG8_MMA(0, 0, At, B0); PG8_MMA(0, 1, At, B1); PG8_BAR; PG8_SCHED;
            PG8_LDA(At, 1, 1); PG8_STAGE(PG8_SB(1, 0), b3, voffB); PG8_STAGE(PG8_SB(1, 1), b3 + hB, voffB); PG8_STAGE(PG8_SA(1, 0), a3, voffA);
            PG8_WAIT_V(8); PG8_WAIT_L(0); PG8_BAR; PG8_MMA(1, 0, At, B0); PG8_MMA(1, 1, At, B1); PG8_BAR; PG8_SCHED;
        }
        if (wr == 0) PG8_BAR;
        E(acc, cur, wr, wc, fr, fq);
        if (!has_next) break;
#pragma unroll
        for (int a = 0; a < 2; ++a)
#pragma unroll
            for (int b = 0; b < 2; ++b)
#pragma unroll
                for (int m = 0; m < 4; ++m)
#pragma unroll
                    for (int n = 0; n < 2; ++n) acc[a][b][m][n] = (f32x4){0.f, 0.f, 0.f, 0.f};
        cur = nxt; cA = nA; cB = nB; ++ui;
        if (wr == 1) PG8_BAR;
    }
    PG8_WAIT_V(0);
    PG8_BAR;
#undef PG8_SA
#undef PG8_SB
#undef PG8_STAGE
#undef PG8_LDA
#undef PG8_LDB
#undef PG8_MMA
#undef PG8_WAIT_V
#undef PG8_WAIT_L
#undef PG8_BAR
#undef PG8_SCHED
}
}

#define XB_TMO      128
#define XB_XCNT(j)  (256  + 64 * (j))
#define XB_XSUB(j)  (1280 + 64 * (j))
#define XB_XGEN(j)  (2304 + 64 * (j))
#define XB_TOP      3328
#define XB_TOPGEN   3392
#define XCD_BAR_WORDS 3456
#define XB_SPIN_CAP (1u << 22)
__device__ __forceinline__ unsigned xb_ld(unsigned* p)              { return __hip_atomic_load(p, __ATOMIC_RELAXED, __HIP_MEMORY_SCOPE_AGENT); }
__device__ __forceinline__ unsigned xb_add(unsigned* p, unsigned v) { return __hip_atomic_fetch_add(p, v, __ATOMIC_RELAXED, __HIP_MEMORY_SCOPE_AGENT); }
__device__ __forceinline__ unsigned xb_xcc_id() { return (unsigned)__builtin_amdgcn_s_getreg((3 << 11) | 20) & 0xFu; }
#define XB_SPIN(cond, bar) do { unsigned _sp = 0; while (cond) { __builtin_amdgcn_s_sleep(1); \
    if ((++_sp & 255u) == 0u) { if (xb_ld(&(bar)[XB_TMO])) break; if (_sp > XB_SPIN_CAP) { atomicAdd(&(bar)[XB_TMO], 1u); break; } } } } while (0)
struct XcdBarrier { unsigned* bar; unsigned x; volatile LAS unsigned* st; };
__device__ __forceinline__ XcdBarrier xcd_barrier_post(unsigned* bar, volatile LAS unsigned* st) {
    XcdBarrier b; b.bar = bar; b.x = xb_xcc_id(); b.st = st;
    if (threadIdx.x == 0) (void)xb_add(&bar[XB_XCNT(b.x)], 1u);
    return b;
}
__device__ __forceinline__ void xcd_barrier_complete(unsigned* bar, unsigned x, unsigned& nloc, unsigned& nx) {
    const unsigned G = gridDim.x * gridDim.y * gridDim.z;
    unsigned sum, cnt, mine, sp = 0u;
    for (;;) {
        sum = 0u; cnt = 0u; mine = 0u;
#pragma unroll
        for (unsigned j = 0; j < 16; ++j) { const unsigned c = xb_ld(&bar[XB_XCNT(j)]); sum += c; cnt += (c > 0u) ? 1u : 0u; mine = (j == x) ? c : mine; }
        if (sum == G) break;
        __builtin_amdgcn_s_sleep(1);
        if ((++sp & 255u) == 0u) { if (xb_ld(&bar[XB_TMO])) break; if (sp > XB_SPIN_CAP) { atomicAdd(&bar[XB_TMO], 1u); break; } }
    }
    nloc = mine > 0u ? mine : 1u; nx = cnt > 0u ? cnt : 1u;
}
__device__ __forceinline__ void xcd_barrier(const XcdBarrier& b) {
    asm volatile("s_waitcnt vmcnt(0)" ::: "memory");
    __syncthreads();
    if (threadIdx.x == 0) {
        unsigned* bar = b.bar;
        __builtin_amdgcn_s_waitcnt(0);
        unsigned nloc = b.st[0], nx = b.st[1];
        if (nloc == 0u) { xcd_barrier_complete(bar, b.x, nloc, nx); b.st[0] = nloc; b.st[1] = nx; }
        const unsigned old = xb_add(&bar[XB_XSUB(b.x)], 1u);
        const unsigned gen = old / nloc;
        if (old + 1u == (gen + 1u) * nloc) {
            __builtin_amdgcn_fence(__ATOMIC_RELEASE, "agent");
            asm volatile("s_waitcnt vmcnt(0)" ::: "memory");
            const unsigned og = xb_add(&bar[XB_TOP], 1u);
            const unsigned tg = og / nx;
            if (og + 1u == (tg + 1u) * nx) xb_add(&bar[XB_TOPGEN], 1u);
            else XB_SPIN(xb_ld(&bar[XB_TOPGEN]) == tg, bar);
            __builtin_amdgcn_fence(__ATOMIC_ACQUIRE, "agent");
            xb_add(&bar[XB_XGEN(b.x)], 1u);
            asm volatile("s_waitcnt vmcnt(0)" ::: "memory");
        } else {
            XB_SPIN(xb_ld(&bar[XB_XGEN(b.x)]) == gen, bar);
            __builtin_amdgcn_fence(__ATOMIC_ACQUIRE, "agent");
            asm volatile("s_waitcnt vmcnt(0)" ::: "memory");
        }
    }
    __syncthreads();
}

struct Args { const float* in[27]; float* out; unsigned char* ws; };

__device__ __forceinline__ float wave_sum(float v) {
#pragma unroll
    for (int o = 1; o < 64; o <<= 1) v += __shfl_xor(v, o);
    return v;
}

__device__ __forceinline__ void tr_item(const float* src, int ld, int c0, int k0, bf16_t* dst, int K, int r0, const float* gain, float scale, LAS float* scr, int lane, int gmask = 0x7fffffff, int glim = 0x7fffffff) {
    f32x4 v[8];
#pragma unroll
    for (int i = 0; i < 8; ++i) { const int kk = (lane >> 3) + 8 * i; v[i] = *(const f32x4*)(src + (size_t)(k0 + kk) * ld + c0 + 4 * (lane & 7)); }
    const int c = lane & 7;
    float gv[8];
#pragma unroll
    for (int e = 0; e < 8; ++e) { const int k = k0 + 8 * c + e; gv[e] = (gain && k < glim) ? gain[k & gmask] * scale : scale; }
#pragma unroll
    for (int i = 0; i < 8; ++i) { const int kk = (lane >> 3) + 8 * i; LAS float* p = scr + kk * 33 + 4 * (lane & 7); p[0] = v[i][0]; p[1] = v[i][1]; p[2] = v[i][2]; p[3] = v[i][3]; }
    asm volatile("s_waitcnt lgkmcnt(0)" ::: "memory"); __builtin_amdgcn_wave_barrier();
#pragma unroll
    for (int j = 0; j < 4; ++j) { const int n = (lane >> 3) + 8 * j; const LAS float* sp = scr + (8 * c) * 33 + n;
        u32x4 o; o.x = pk2(sp[0 * 33] * gv[0], sp[1 * 33] * gv[1]); o.y = pk2(sp[2 * 33] * gv[2], sp[3 * 33] * gv[3]); o.z = pk2(sp[4 * 33] * gv[4], sp[5 * 33] * gv[5]); o.w = pk2(sp[6 * 33] * gv[6], sp[7 * 33] * gv[7]);
        *(u32x4*)(dst + (size_t)(r0 + n) * K + k0 + 8 * c) = o; }
    asm volatile("s_waitcnt lgkmcnt(0)" ::: "memory"); __builtin_amdgcn_wave_barrier();
}

constexpr int IT_UP = 4 * 2816, IT_DN = 4 * 1408, IT_IN0 = 1280, IT_IN1 = 2048, IT_SQ = 4 * 512, IT_PROJ = 256, IT_GP = 128, IT_LRU = 32;
constexpr int IT_TOTAL = IT_UP + IT_DN + IT_IN0 + IT_IN1 + IT_SQ + IT_PROJ + IT_GP + IT_LRU;

__device__ __forceinline__ void pre_phase(const Args& a, LAS unsigned char* lds, int vcu, int wave, int lane, int part) {
    unsigned char* ws = a.ws;
    LAS float* scr = (LAS float*)(lds + wave * 16384);
    const int gw = vcu * 8 + wave, NGW = 256 * 8;
    const int it_lo = part == 0 ? 0 : 2816, it_hi = part == 0 ? 2816 : IT_TOTAL;
    for (int it = it_lo + gw; it < it_hi; it += NGW) {
        int r = it;
        if (r < IT_UP) { const int mat = r / 2816, q = r % 2816, rb = q / 16, kb = q % 16, pn = rb / 8, half = (rb % 8) / 4, jb = rb % 4;
            const float* src = (half ? a.in[4] : a.in[3]) + (size_t)mat * DM * FF;
            tr_item(src, FF, 128 * pn + 32 * jb, 64 * kb, (bf16_t*)(ws + WS_WUP) + (size_t)mat * 5632 * DM, DM, 32 * rb, a.in[2] + mat * DM, 1.0f, scr, lane); continue; }
        r -= IT_UP;
        if (r < IT_DN) { const int mat = r / 1408, q = r % 1408, rb = q / 44, kb = q % 44;
            tr_item(a.in[5] + (size_t)mat * FF * DM, DM, 32 * rb, 64 * kb, (bf16_t*)(ws + WS_WDN) + (size_t)mat * DM * FF, FF, 32 * rb, nullptr, 1.0f, scr, lane); continue; }
        r -= IT_DN;
        if (r < IT_IN0) { const int rb = r / 16, kb = r % 16, row = 32 * rb; int c0; float sc = 1.0f;
            if (row < 256) { c0 = row; sc = 0.125f; } else if (row < 1024) c0 = row; else if (row < 1536) c0 = 2064 + (row - 1024); else if (row < 2048) c0 = 1552 + (row - 1536); else c0 = 1024 + (row - 2048);
            tr_item(a.in[11], 2576, c0, 64 * kb, (bf16_t*)(ws + WS_WIN0), DM, row, a.in[6], sc, scr, lane); continue; }
        r -= IT_IN0;
        if (r < IT_IN1) { const int rb = r / 16, kb = r % 16;
            tr_item(a.in[23], 4096, 32 * rb, 64 * kb, (bf16_t*)(ws + WS_WIN1), DM, 32 * rb, a.in[6] + DM, 1.0f, scr, lane); continue; }
        r -= IT_IN1;
        if (r < IT_SQ) { const int mat = r / 512, q = r % 512, rb = q / 16, kb = q % 16;
            const float* src = mat == 0 ? a.in[22] : mat == 1 ? a.in[26] : mat == 2 ? a.in[9] : a.in[9] + (size_t)DM * DM;
            bf16_t* dst = mat < 2 ? (bf16_t*)(ws + WS_WOUT) + (size_t)mat * DM * DM : (bf16_t*)(ws + WS_WGATE) + (size_t)(mat - 2) * DM * DM;
            const float* gn = mat == 0 ? a.in[14] : mat == 1 ? a.in[25] : a.in[7] + (mat - 2) * DM;
            tr_item(src, DM, 32 * rb, 64 * kb, dst, DM, 32 * rb, gn, 1.0f, scr, lane, mat < 2 ? 127 : 0x7fffffff, mat == 0 ? 512 : 0x7fffffff); continue; }
        r -= IT_SQ;
        if (r < IT_PROJ) { const int mat = r / 128, q = r % 128, rb = q / 4, kb = q % 4;
            tr_item(a.in[8] + (size_t)mat * 256 * DM, DM, 32 * rb, 64 * kb, (bf16_t*)(ws + WS_WPROJ) + (size_t)mat * DM * 256, 256, 32 * rb, nullptr, 1.0f, scr, lane); continue; }
        r -= IT_PROJ;
        if (r < IT_GP) {
            const int nb = r / 16, kb = r % 16, c = lane & 7; const float* win = a.in[11]; const float* gu = a.in[12]; const float* gn = a.in[6];
#pragma unroll 1
            for (int j = 0; j < 4; ++j) { const int n = 32 * nb + (lane >> 3) + 8 * j; float o[8];
#pragma unroll
                for (int e = 0; e < 8; ++e) { const int k = 64 * kb + 8 * c + e; float s = 0.f;
#pragma unroll
                    for (int rr = 0; rr < 16; ++rr) s += win[(size_t)k * 2576 + 1536 + rr] * gu[rr * 256 + n];
                    o[e] = s * gn[k]; }
                u32x4 w; w.x = pk2(o[0], o[1]); w.y = pk2(o[2], o[3]); w.z = pk2(o[4], o[5]); w.w = pk2(o[6], o[7]);
                *(u32x4*)((bf16_t*)(ws + WS_WIN0) + (size_t)(GP0 + n) * DM + 64 * kb + 8 * c) = w; }
            continue; }
        r -= IT_GP;
        { const int mat = r / 16, q = r % 16, g = q / 2, rb = q % 2;
            tr_item((mat ? a.in[19] : a.in[17]) + g * 4096, 64, 32 * rb, 0, (bf16_t*)(ws + WS_WLRU) + mat * 32768 + g * 4096, 64, 32 * rb, nullptr, 1.0f, scr, lane); }
    }
    if (part != 0) return;
    const float* x = a.in[0]; bf16_t* XB = (bf16_t*)(ws + WS_XB); float* SS = (float*)(ws + WS_SS0);
    for (int m0 = 4 * gw; m0 < MTOK; m0 += 4 * NGW) {
        f32x4 v[4][4];
#pragma unroll
        for (int r = 0; r < 4; ++r)
#pragma unroll
            for (int j = 0; j < 4; ++j) v[r][j] = *((const f32x4*)(x + (size_t)(m0 + r) * DM) + lane + 64 * j);
#pragma unroll
        for (int r = 0; r < 4; ++r) {
            float s = 0.f;
#pragma unroll
            for (int j = 0; j < 4; ++j) s += (v[r][j][0] * v[r][j][0] + v[r][j][1] * v[r][j][1]) + (v[r][j][2] * v[r][j][2] + v[r][j][3] * v[r][j][3]);
            s = wave_sum(s);
            u32x2* o = (u32x2*)(XB + (size_t)(m0 + r) * DM) + lane;
#pragma unroll
            for (int j = 0; j < 4; ++j) { u32x2 w; w.x = pk2(v[r][j][0], v[r][j][1]); w.y = pk2(v[r][j][2], v[r][j][3]); o[64 * j] = w; }
            if (lane < 16) SS[(size_t)(m0 + r) * 16 + lane] = lane == 0 ? s : 0.f;
        }
    }
}

__device__ __forceinline__ void pconv_phase(const float* p, bf16_t* PB, int gtid) {
    const f32x4* src = (const f32x4*)p; u32x2* dst = (u32x2*)PB;
    for (int i = gtid; i < MTOK * 256 / 4; i += 256 * 512) { const f32x4 v = src[i]; u32x2 w; w.x = pk2(v[0], v[1]); w.y = pk2(v[2], v[3]); dst[i] = w; }
}

template <int L>
__device__ __forceinline__ void p1_load(const bf16_t* Z, int task, int tid, u32x4& r0, u32x4& r1, u32x4& r2, u32x4& r3) {
    constexpr int H = L ? 8 : 4, LDZ = L ? LDZ1 : LDZ0;
    const int h = task % H; const size_t tok0 = (size_t)(task / H) * 64;
    if (L == 0) {
        const int row = tid >> 3, c16 = tid & 7;
        r0 = *(const u32x4*)(Z + (tok0 + row) * LDZ + GP0 + 64 * h + 8 * c16);
        r1 = *(const u32x4*)(Z + (tok0 + row) * LDZ + K0 + 64 * h + 8 * c16);
        const int rv = tid >> 4, cv = tid & 15;
        r2 = *(const u32x4*)(Z + (tok0 + rv) * LDZ + V0 + 128 * h + 8 * cv);
        r3 = *(const u32x4*)(Z + (tok0 + 32 + rv) * LDZ + V0 + 128 * h + 8 * cv);
    } else {
        const int rv = tid >> 4, cv = tid & 15;
        r0 = *(const u32x4*)(Z + (tok0 + rv) * LDZ + FZ1 + 128 * h + 8 * cv);
        r1 = *(const u32x4*)(Z + (tok0 + 32 + rv) * LDZ + FZ1 + 128 * h + 8 * cv);
        r2 = *(const u32x4*)(Z + (tok0 + rv) * LDZ + I1 + 128 * h + 8 * cv);
        r3 = *(const u32x4*)(Z + (tok0 + 32 + rv) * LDZ + I1 + 128 * h + 8 * cv);
    }
}
template <int L>
__device__ __forceinline__ void p1_phase(const Args& a, LAS unsigned char* lds, int bx, int tid, int ntasks) {
    constexpr int DK = L ? 128 : 64, H = L ? 8 : 4, SEGS = 512 / DK, TPS = 64 / SEGS, LDZ = L ? LDZ1 : LDZ0;
    unsigned char* ws = a.ws;
    bf16_t* Z = (bf16_t*)(ws + WS_Z);
    float* GC = (float*)(ws + WS_GC);
    LAS bf16_t* NATA = (LAS bf16_t*)lds;
    LAS bf16_t* NATK = (LAS bf16_t*)(lds + 16384);
    LAS bf16_t* NATV = (LAS bf16_t*)(lds + 24576);
    LAS bf16_t* KD = (LAS bf16_t*)(lds + 40960);
    LAS bf16_t* VT = (LAS bf16_t*)(lds + 59392);
    LAS float* SEG = (LAS float*)(lds + 77824);
    const int lane = tid & 63, wid = tid >> 6;
    u32x4 r0, r1, r2, r3;
    int task = bx;
    const int h = bx % H, d = tid % DK, seg = tid / DK;
    float cst0, cst1;
    if (L == 0) { cst0 = a.in[13][64 * h + d]; cst1 = 0.f; } else { const float l0 = a.in[24][128 * h + d], l1 = a.in[24][1024 + 128 * h + d]; cst0 = fast_sigmoid(l1 - l0); cst1 = 1.0f - cst0; }
    if (task < ntasks) p1_load<L>(Z, task, tid, r0, r1, r2, r3);
    for (; task < ntasks; task += 256) {
        const size_t tok0 = (size_t)(task / H) * 64;
        if (L == 0) { *(LAS u32x4*)(NATA + tid * 8) = r0; *(LAS u32x4*)(NATK + tid * 8) = r1; *(LAS u32x4*)(NATV + tid * 8) = r2; *(LAS u32x4*)(NATV + 4096 + tid * 8) = r3; }
        else { *(LAS u32x4*)(NATA + tid * 8) = r0; *(LAS u32x4*)(NATA + 4096 + tid * 8) = r1; *(LAS u32x4*)(NATV + tid * 8) = r2; *(LAS u32x4*)(NATV + 4096 + tid * 8) = r3; }
        __syncthreads();
        if (task + 256 < ntasks) p1_load<L>(Z, task + 256, tid, r0, r1, r2, r3);
        float lf[TPS], kk[TPS];
        if (L == 0) {
            const float bias = cst0;
#pragma unroll
            for (int i = 0; i < TPS; ++i) { const int t = seg * TPS + i;
                const float gp = bf2f(NATA[t * 64 + d]) + bias;
                lf[i] = (fminf(gp, 0.f) - flog(1.0f + fexp(-fabsf(gp)))) * (1.0f / 16.0f); kk[i] = bf2f(NATK[t * 64 + d]); }
        } else {
            const float lb = cst0, omlb = cst1;
#pragma unroll
            for (int i = 0; i < TPS; ++i) { const int t = seg * TPS + i;
                const float zz = bf2f(NATA[t * 128 + d]); const float sg = fast_sigmoid(zz);
                lf[i] = flog(lb + omlb * sg); kk[i] = omlb * (1.0f - sg); }
        }
        float run = 0.f;
#pragma unroll
        for (int i = 0; i < TPS; ++i) { run += lf[i]; lf[i] = run; }
        SEG[seg * DK + d] = run;
        __syncthreads();
        {
            float off = 0.f, total = 0.f;
#pragma unroll
            for (int sg = 0; sg < SEGS; ++sg) { const float v = SEG[sg * DK + d]; total += v; off += (sg < seg) ? v : 0.f; }
            unsigned w[TPS / 2];
#pragma unroll
            for (int i = 0; i < TPS; i += 2) w[i / 2] = cvt_pk_bf16(kk[i] * fexp(total - (off + lf[i])), kk[i + 1] * fexp(total - (off + lf[i + 1])));
#pragma unroll
            for (int i = 0; i < TPS / 8; ++i) { u32x4 o; o.x = w[4 * i]; o.y = w[4 * i + 1]; o.z = w[4 * i + 2]; o.w = w[4 * i + 3];
                *(LAS u32x4*)(KD + d * 72 + seg * TPS + 8 * i) = o; }
            if (seg == 0) GC[(size_t)task * DK + d] = fexp(total);
        }
        {
            const int dv = tid & 127, tq = tid >> 7;
            unsigned w[8];
#pragma unroll
            for (int i = 0; i < 16; i += 2) { const unsigned lo = NATV[(16 * tq + i) * 128 + dv], hi = NATV[(16 * tq + i + 1) * 128 + dv]; w[i / 2] = lo | (hi << 16); }
            u32x4 o0, o1; o0.x = w[0]; o0.y = w[1]; o0.z = w[2]; o0.w = w[3]; o1.x = w[4]; o1.y = w[5]; o1.z = w[6]; o1.w = w[7];
            *(LAS u32x4*)(VT + dv * 72 + 16 * tq) = o0; *(LAS u32x4*)(VT + dv * 72 + 16 * tq + 8) = o1;
        }
        __syncthreads();
        {
            const int cj = lane & 15, q = lane >> 4;
            bf16x8 vf[2];
#pragma unroll
            for (int ks = 0; ks < 2; ++ks) vf[ks] = *(const LAS bf16x8*)(VT + (16 * wid + cj) * 72 + 32 * ks + 8 * q);
#pragma unroll
            for (int kt = 0; kt < DK / 16; ++kt) {
                f32x4 acc = (f32x4){0.f, 0.f, 0.f, 0.f};
#pragma unroll
                for (int ks = 0; ks < 2; ++ks) { const bf16x8 kf = *(const LAS bf16x8*)(KD + (16 * kt + cj) * 72 + 32 * ks + 8 * q);
                    acc = __builtin_amdgcn_mfma_f32_16x16x32_bf16(kf, vf[ks], acc, 0, 0, 0); }
                u32x2 o; o.x = cvt_pk_bf16(acc[0], acc[1]); o.y = cvt_pk_bf16(acc[2], acc[3]);
                const int dv = 16 * wid + cj, dk = 16 * kt + 4 * q;
                if (L == 0) *(u32x2*)((bf16_t*)(ws + WS_KV0) + ((size_t)task * 128 + dv) * 64 + dk) = o;
                else *(u32x2*)(Z + (tok0 + (dv & 63)) * LDZ + (dv < 64 ? FZ1 : I1) + 128 * h + dk) = o;
            }
        }
    }
    __syncthreads();
}

template <int L>
__device__ __forceinline__ void p2_phase(const Args& a, int gtid) {
    constexpr int DK = L ? 128 : 64, H = L ? 8 : 4, EPT = L ? 8 : 2, DKG = DK / EPT, LDZ = L ? LDZ1 : LDZ0;
    unsigned char* ws = a.ws;
    const int dkg = gtid % DKG, dv = (gtid / DKG) % 128, bh = gtid / (DKG * 128), h = bh % H, b = bh / H;
    const float* GC = (const float*)(ws + WS_GC);
    bf16_t* base; size_t cstride;
    if (L == 0) { base = (bf16_t*)(ws + WS_KV0) + (((size_t)(b * 64) * 4 + h) * 128 + dv) * 64 + EPT * dkg; cstride = (size_t)4 * 128 * 64; }
    else { base = (bf16_t*)(ws + WS_Z) + ((size_t)b * SEQ + (dv & 63)) * LDZ + (dv < 64 ? FZ1 : I1) + 128 * h + EPT * dkg; cstride = (size_t)64 * LDZ; }
    const float* gcb = GC + ((size_t)(b * 64) * H + h) * DK + EPT * dkg; const size_t gstride = (size_t)H * DK;
    if (L == 1) {
        float S[8];
#pragma unroll
        for (int e = 0; e < 8; ++e) S[e] = 0.f;
#pragma unroll 1
        for (int c0 = 0; c0 < NCHUNK; c0 += 8) {
            u32x4 kv[8]; f32x4 g0[8], g1[8];
#pragma unroll
            for (int i = 0; i < 8; ++i) { kv[i] = *(const u32x4*)(base + (size_t)(c0 + i) * cstride); g0[i] = *(const f32x4*)(gcb + (size_t)(c0 + i) * gstride); g1[i] = *(const f32x4*)(gcb + (size_t)(c0 + i) * gstride + 4); }
#pragma unroll
            for (int i = 0; i < 8; ++i) {
                S[0] = g0[i][0] * S[0] + bflo(kv[i].x); S[1] = g0[i][1] * S[1] + bfhi(kv[i].x); S[2] = g0[i][2] * S[2] + bflo(kv[i].y); S[3] = g0[i][3] * S[3] + bfhi(kv[i].y);
                S[4] = g1[i][0] * S[4] + bflo(kv[i].z); S[5] = g1[i][1] * S[5] + bfhi(kv[i].z); S[6] = g1[i][2] * S[6] + bflo(kv[i].w); S[7] = g1[i][3] * S[7] + bfhi(kv[i].w);
                u32x4 o; o.x = pk2(S[0], S[1]); o.y = pk2(S[2], S[3]); o.z = pk2(S[4], S[5]); o.w = pk2(S[6], S[7]);
                *(u32x4*)(base + (size_t)(c0 + i) * cstride) = o;
            }
        }
    } else {
        float S0 = 0.f, S1 = 0.f;
#pragma unroll 1
        for (int c0 = 0; c0 < NCHUNK; c0 += 16) {
            unsigned kv[16]; f32x2 g[16];
#pragma unroll
            for (int i = 0; i < 16; ++i) { kv[i] = *(const unsigned*)(base + (size_t)(c0 + i) * cstride); g[i] = *(const f32x2*)(gcb + (size_t)(c0 + i) * gstride); }
#pragma unroll
            for (int i = 0; i < 16; ++i) { S0 = g[i][0] * S0 + bflo(kv[i]); S1 = g[i][1] * S1 + bfhi(kv[i]); *(unsigned*)(base + (size_t)(c0 + i) * cstride) = pk2(S0, S1); }
        }
    }
}

template <int L>
__device__ __forceinline__ void p3_wtask(const Args& a, int wt, int lane) {
    constexpr int DK = L ? 128 : 64, H = L ? 8 : 4, KS = DK / 32, LDZ = L ? LDZ1 : LDZ0;
    unsigned char* ws = a.ws;
    bf16_t* Z = (bf16_t*)(ws + WS_Z);
    const int task = wt, h = task % H; const size_t tok0 = (size_t)(task / H) * 64;
    const int cj = lane & 15, q = lane >> 4;
    bf16x8 sf[8][KS];
#pragma unroll
    for (int dt = 0; dt < 8; ++dt) {
        const int dv = 16 * dt + cj;
        const bf16_t* srow = (L == 0) ? (const bf16_t*)(ws + WS_KV0) + ((size_t)task * 128 + dv) * 64 : Z + (tok0 + (dv & 63)) * LDZ + (dv < 64 ? FZ1 : I1) + 128 * h;
#pragma unroll
        for (int ks = 0; ks < KS; ++ks) sf[dt][ks] = *(const bf16x8*)(srow + 32 * ks + 8 * q);
    }
    u32x4 qn[KS];
#pragma unroll
    for (int ks = 0; ks < KS; ++ks) qn[ks] = *(const u32x4*)(Z + (tok0 + cj) * LDZ + (L ? Q1 : Q0) + DK * h + 32 * ks + 8 * q);
#pragma unroll 1
    for (int ti = 0; ti < 4; ++ti) {
        const size_t rowo = (tok0 + 16 * ti + cj) * LDZ;
        bf16x8 qf[KS];
#pragma unroll
        for (int ks = 0; ks < KS; ++ks) { u32x4 w = qn[ks];
            if (L == 1) { w.x = pk2(fast_silu(bflo(w.x)), fast_silu(bfhi(w.x))); w.y = pk2(fast_silu(bflo(w.y)), fast_silu(bfhi(w.y))); w.z = pk2(fast_silu(bflo(w.z)), fast_silu(bfhi(w.z))); w.w = pk2(fast_silu(bflo(w.w)), fast_silu(bfhi(w.w))); }
            qf[ks] = __builtin_bit_cast(bf16x8, w); }
        if (ti < 3) {
#pragma unroll
            for (int ks = 0; ks < KS; ++ks) qn[ks] = *(const u32x4*)(Z + rowo + (size_t)16 * LDZ + (L ? Q1 : Q0) + DK * h + 32 * ks + 8 * q);
        }
        u32x2 gw[8];
#pragma unroll
        for (int dt = 0; dt < 8; ++dt) gw[dt] = *(const u32x2*)(Z + rowo + (L ? G1 : G0) + 128 * h + 16 * dt + 4 * q);
        f32x4 acc[8];
#pragma unroll
        for (int dt = 0; dt < 8; ++dt) {
            acc[dt] = (f32x4){0.f, 0.f, 0.f, 0.f};
#pragma unroll
            for (int ks = 0; ks < KS; ++ks) acc[dt] = __builtin_amdgcn_mfma_f32_16x16x32_bf16(sf[dt][ks], qf[ks], acc[dt], 0, 0, 0);
        }
        float ss = 0.f;
#pragma unroll
        for (int dt = 0; dt < 8; ++dt) ss += (acc[dt][0] * acc[dt][0] + acc[dt][1] * acc[dt][1]) + (acc[dt][2] * acc[dt][2] + acc[dt][3] * acc[dt][3]);
        ss += __shfl_xor(ss, 16); ss += __shfl_xor(ss, 32);
        const float rstd = __builtin_amdgcn_rsqf(ss * (1.0f / 128.0f) + EPS);
#pragma unroll
        for (int dt = 0; dt < 8; ++dt) {
            const int dv0 = 16 * dt + 4 * q;
            const float o0 = acc[dt][0] * rstd * fast_silu(bflo(gw[dt].x)), o1 = acc[dt][1] * rstd * fast_silu(bfhi(gw[dt].x));
            const float o2 = acc[dt][2] * rstd * fast_silu(bflo(gw[dt].y)), o3 = acc[dt][3] * rstd * fast_silu(bfhi(gw[dt].y));
            u32x2 o; o.x = cvt_pk_bf16(o0, o1); o.y = cvt_pk_bf16(o2, o3);
            *(u32x2*)(Z + rowo + (L ? Q1 : V0) + 128 * h + dv0) = o;
        }
    }
}

template <bool FINAL>
__device__ __forceinline__ void lru_phase(const Args& a, LAS unsigned char* lds, int bx, int wid, int lane) {
    unsigned char* ws = a.ws;
    bf16_t* Z = (bf16_t*)(ws + WS_Z);
    const bf16_t* WAT = (const bf16_t*)(ws + WS_WLRU); const bf16_t* WXT = WAT + 32768;
    float* SUMA = (float*)(ws + WS_SUMA); float* SUMH = (float*)(ws + WS_SUMH);
    const int g = wid, cj = lane & 15, q = lane >> 4;
    LAS float* AL = (LAS float*)(lds + wid * 17408); LAS float* UL = AL + 16 * 68;
    LAS float* LL = AL + 2 * 16 * 68;
    LAS float* CW = AL + 3 * 16 * 68;
    bf16_t* LAg = (bf16_t*)(ws + WS_XB2); bf16_t* Ug = LAg + (size_t)MTOK * 512;
    { const int ch = 64 * g + lane;
#pragma unroll
      for (int j = 0; j < 4; ++j) CW[j * 64 + lane] = a.in[15][j * 512 + ch];
      CW[256 + lane] = a.in[16][ch]; }
    float cba[4], cbx[4], cls[4];
#pragma unroll
    for (int jt = 0; jt < 4; ++jt) { const int chj = 64 * g + 16 * jt + cj; cba[jt] = a.in[18][chj]; cbx[jt] = a.in[20][chj]; cls[jt] = 8.0f * 1.44269504089f * logsigmoidf_(a.in[21][chj]); }
    asm volatile("s_waitcnt lgkmcnt(0)" ::: "memory"); __builtin_amdgcn_wave_barrier();
#pragma unroll 1
    for (int task = bx; task < 512; task += 256) {
        const int c = task & 63; const size_t tok0 = (size_t)task * 64;
        float hcar = 0.f, atot = 1.f;
        if (FINAL) {
            const float* pa = SUMA + (size_t)(task & ~63) * 512 + 64 * g + lane; const float* ph = SUMH + (size_t)(task & ~63) * 512 + 64 * g + lane;
            int cc = 0;
#pragma unroll 1
            for (; cc + 8 <= c; cc += 8) { float av[8], hv[8];
#pragma unroll
                for (int i = 0; i < 8; ++i) { av[i] = pa[(size_t)(cc + i) * 512]; hv[i] = ph[(size_t)(cc + i) * 512]; }
#pragma unroll
                for (int i = 0; i < 8; ++i) hcar = av[i] * hcar + hv[i]; }
#pragma unroll 1
            for (; cc < c; ++cc) hcar = pa[(size_t)cc * 512] * hcar + ph[(size_t)cc * 512];
        }
#pragma unroll 1
        for (int tt = 0; tt < 4; ++tt) {
            u32x4 xw[2][4];
#pragma unroll
            for (int ks = 0; ks < 2; ++ks)
#pragma unroll
                for (int j = 0; j < 4; ++j) { const int tj = 16 * tt + cj - 3 + j; xw[ks][j] = (u32x4){0u, 0u, 0u, 0u};
                    if (c > 0 || tj >= 0) xw[ks][j] = *(const u32x4*)(Z + (size_t)((long)tok0 + tj) * LDZ0 + XR0 + 64 * g + 32 * ks + 8 * q); }
            bf16x8 waf[4][2], wxf[4][2];
#pragma unroll
            for (int jt = 0; jt < 4; ++jt)
#pragma unroll
                for (int ks = 0; ks < 2; ++ks) {
                    waf[jt][ks] = *(const bf16x8*)(WAT + g * 4096 + (16 * jt + cj) * 64 + 32 * ks + 8 * q);
                    wxf[jt][ks] = *(const bf16x8*)(WXT + g * 4096 + (16 * jt + cj) * 64 + 32 * ks + 8 * q); }
            u32x4 xgv[2];
            if (FINAL) {
#pragma unroll
                for (int it = 0; it < 2; ++it) xgv[it] = *(const u32x4*)(Z + (tok0 + 16 * tt + (lane >> 3) + 8 * it) * LDZ0 + XG0 + 64 * g + (lane & 7) * 8);
            }
            bf16x8 xf[2];
#pragma unroll
            for (int ks = 0; ks < 2; ++ks) {
                const int cl = 32 * ks + 8 * q;
                const f32x4 b0 = *(const LAS f32x4*)(CW + 256 + cl), b1 = *(const LAS f32x4*)(CW + 256 + cl + 4);
                float xc[8] = {b0[0], b0[1], b0[2], b0[3], b1[0], b1[1], b1[2], b1[3]};
#pragma unroll
                for (int j = 0; j < 4; ++j) {
                    const u32x4 w = xw[ks][j];
                    const f32x4 c0 = *(const LAS f32x4*)(CW + j * 64 + cl), c1 = *(const LAS f32x4*)(CW + j * 64 + cl + 4);
                    xc[0] += c0[0] * bflo(w.x); xc[1] += c0[1] * bfhi(w.x); xc[2] += c0[2] * bflo(w.y); xc[3] += c0[3] * bfhi(w.y);
                    xc[4] += c1[0] * bflo(w.z); xc[5] += c1[1] * bfhi(w.z); xc[6] += c1[2] * bflo(w.w); xc[7] += c1[3] * bfhi(w.w);
                }
                u32x4 o; o.x = pk2(xc[0], xc[1]); o.y = pk2(xc[2], xc[3]); o.z = pk2(xc[4], xc[5]); o.w = pk2(xc[6], xc[7]);
                xf[ks] = __builtin_bit_cast(bf16x8, o);
            }
#pragma unroll
            for (int jt = 0; jt < 4; ++jt) {
                f32x4 aa = (f32x4){0.f, 0.f, 0.f, 0.f}, ax = aa, ac = aa;
#pragma unroll
                for (int ks = 0; ks < 2; ++ks) {
                    bf16x8 idf;
#pragma unroll
                    for (int e = 0; e < 8; ++e) idf[e] = (32 * ks + 8 * q + e == 16 * jt + cj) ? (short)0x3F80 : (short)0;
                    aa = __builtin_amdgcn_mfma_f32_16x16x32_bf16(xf[ks], waf[jt][ks], aa, 0, 0, 0);
                    ax = __builtin_amdgcn_mfma_f32_16x16x32_bf16(xf[ks], wxf[jt][ks], ax, 0, 0, 0);
                    ac = __builtin_amdgcn_mfma_f32_16x16x32_bf16(xf[ks], idf, ac, 0, 0, 0);
                }
#pragma unroll
                for (int r = 0; r < 4; ++r) {
                    const float rg = fast_sigmoid(aa[r] + cba[jt]), ig = fast_sigmoid(ax[r] + cbx[jt]);
                    const float la = bflo(pk2(cls[jt] * rg, 0.f));
                    const float av = __builtin_amdgcn_exp2f(la);
                    const float uv = bflo(pk2(__builtin_amdgcn_sqrtf(fmaxf(1.0f - av * av, 0.f)) * (ig * ac[r]), 0.f));
                    AL[(4 * q + r) * 68 + 16 * jt + cj] = av; UL[(4 * q + r) * 68 + 16 * jt + cj] = uv; if (!FINAL) LL[(4 * q + r) * 68 + 16 * jt + cj] = la;
                }
            }
            asm volatile("s_waitcnt lgkmcnt(0)" ::: "memory"); __builtin_amdgcn_wave_barrier();
            if (!FINAL) {
#pragma unroll
                for (int it = 0; it < 2; ++it) {
                    const int tl = (lane >> 3) + 8 * it, ch8 = (lane & 7) * 8;
                    const f32x4 l0 = *(const LAS f32x4*)(LL + tl * 68 + ch8), l1 = *(const LAS f32x4*)(LL + tl * 68 + ch8 + 4);
                    const f32x4 u0 = *(const LAS f32x4*)(UL + tl * 68 + ch8), u1 = *(const LAS f32x4*)(UL + tl * 68 + ch8 + 4);
                    u32x4 ol, ou;
                    ol.x = pk2(l0[0], l0[1]); ol.y = pk2(l0[2], l0[3]); ol.z = pk2(l1[0], l1[1]); ol.w = pk2(l1[2], l1[3]);
                    ou.x = pk2(u0[0], u0[1]); ou.y = pk2(u0[2], u0[3]); ou.z = pk2(u1[0], u1[1]); ou.w = pk2(u1[2], u1[3]);
                    const size_t o = (tok0 + 16 * tt + tl) * 512 + 64 * g + ch8;
                    *(u32x4*)(LAg + o) = ol; *(u32x4*)(Ug + o) = ou;
                }
            }
#pragma unroll 4
            for (int tl = 0; tl < 16; ++tl) { const float av = AL[tl * 68 + lane], uv = UL[tl * 68 + lane]; hcar = av * hcar + uv; atot *= av; if (FINAL) UL[tl * 68 + lane] = hcar; }
            asm volatile("s_waitcnt lgkmcnt(0)" ::: "memory"); __builtin_amdgcn_wave_barrier();
            if (FINAL) {
#pragma unroll
                for (int it = 0; it < 2; ++it) {
                    const int tl = (lane >> 3) + 8 * it, ch8 = (lane & 7) * 8;
                    const f32x4 h0 = *(const LAS f32x4*)(UL + tl * 68 + ch8), h1 = *(const LAS f32x4*)(UL + tl * 68 + ch8 + 4);
                    const u32x4 xg = xgv[it];
                    u32x4 o;
                    o.x = pk2(h0[0] * fast_gelu_tanh(bflo(xg.x)), h0[1] * fast_gelu_tanh(bfhi(xg.x))); o.y = pk2(h0[2] * fast_gelu_tanh(bflo(xg.y)), h0[3] * fast_gelu_tanh(bfhi(xg.y)));
                    o.z = pk2(h1[0] * fast_gelu_tanh(bflo(xg.z)), h1[1] * fast_gelu_tanh(bfhi(xg.z))); o.w = pk2(h1[2] * fast_gelu_tanh(bflo(xg.w)), h1[3] * fast_gelu_tanh(bfhi(xg.w)));
                    *(u32x4*)(Z + (tok0 + 16 * tt + tl) * LDZ0 + XG0 + 64 * g + ch8) = o;
                }
                asm volatile("s_waitcnt lgkmcnt(0)" ::: "memory"); __builtin_amdgcn_wave_barrier();
            }
        }
        if (!FINAL) { const size_t o = (size_t)task * 512 + 64 * g + lane; SUMA[o] = atot; SUMH[o] = hcar; }
    }
}

__device__ __forceinline__ void lru_apply_phase(const Args& a, LAS unsigned char* lds, int bx, int wid, int lane) {
    unsigned char* ws = a.ws;
    bf16_t* Z = (bf16_t*)(ws + WS_Z);
    const bf16_t* LAg = (const bf16_t*)(ws + WS_XB2); const bf16_t* Ug = LAg + (size_t)MTOK * 512;
    const float* SUMA = (const float*)(ws + WS_SUMA); const float* SUMH = (const float*)(ws + WS_SUMH);
    const int g = wid;
    LAS float* AL = (LAS float*)(lds + wid * 17408); LAS float* UL = AL + 16 * 68;
    const int tr = lane >> 3, ch8 = (lane & 7) * 8;
#pragma unroll 1
    for (int ti = 0; ti < 2; ++ti) {
        const int task = ti == 0 ? bx : ((bx >> 6) + 4) * 64 + (63 - (bx & 63));
        const int c = task & 63; const size_t tok0 = (size_t)task * 64;
        u32x4 lav[2], uvv[2], xgv[2];
#define LRU2_LOAD(TT) do { _Pragma("unroll") for (int it = 0; it < 2; ++it) { const size_t row = tok0 + 16 * (TT) + tr + 8 * it; \
            lav[it] = *(const u32x4*)(LAg + row * 512 + 64 * g + ch8); uvv[it] = *(const u32x4*)(Ug + row * 512 + 64 * g + ch8); \
            xgv[it] = *(const u32x4*)(Z + row * LDZ0 + XG0 + 64 * g + ch8); } } while (0)
        LRU2_LOAD(0);
        float hcar = 0.f;
        {
            const float* pa = SUMA + (size_t)(task & ~63) * 512 + 64 * g + lane; const float* ph = SUMH + (size_t)(task & ~63) * 512 + 64 * g + lane;
            int cc = 0;
#pragma unroll 1
            for (; cc + 16 <= c; cc += 16) { float av[16], hv[16];
#pragma unroll
                for (int i = 0; i < 16; ++i) { av[i] = pa[(size_t)(cc + i) * 512]; hv[i] = ph[(size_t)(cc + i) * 512]; }
#pragma unroll
                for (int i = 0; i < 16; ++i) hcar = av[i] * hcar + hv[i]; }
#pragma unroll 1
            for (; cc + 4 <= c; cc += 4) { float av[4], hv[4];
#pragma unroll
                for (int i = 0; i < 4; ++i) { av[i] = pa[(size_t)(cc + i) * 512]; hv[i] = ph[(size_t)(cc + i) * 512]; }
#pragma unroll
                for (int i = 0; i < 4; ++i) hcar = av[i] * hcar + hv[i]; }
#pragma unroll 1
            for (; cc < c; ++cc) hcar = pa[(size_t)cc * 512] * hcar + ph[(size_t)cc * 512];
        }
#pragma unroll 1
        for (int tt = 0; tt < 4; ++tt) {
            u32x4 xg[2];
#pragma unroll
            for (int it = 0; it < 2; ++it) {
                const int tl = tr + 8 * it; const u32x4 lw = lav[it], uw = uvv[it]; xg[it] = xgv[it];
                const f32x4 a0 = (f32x4){__builtin_amdgcn_exp2f(bflo(lw.x)), __builtin_amdgcn_exp2f(bfhi(lw.x)), __builtin_amdgcn_exp2f(bflo(lw.y)), __builtin_amdgcn_exp2f(bfhi(lw.y))};
                const f32x4 a1 = (f32x4){__builtin_amdgcn_exp2f(bflo(lw.z)), __builtin_amdgcn_exp2f(bfhi(lw.z)), __builtin_amdgcn_exp2f(bflo(lw.w)), __builtin_amdgcn_exp2f(bfhi(lw.w))};
                *(LAS f32x4*)(AL + tl * 68 + ch8) = a0; *(LAS f32x4*)(AL + tl * 68 + ch8 + 4) = a1;
                *(LAS f32x4*)(UL + tl * 68 + ch8) = (f32x4){bflo(uw.x), bfhi(uw.x), bflo(uw.y), bfhi(uw.y)}; *(LAS f32x4*)(UL + tl * 68 + ch8 + 4) = (f32x4){bflo(uw.z), bfhi(uw.z), bflo(uw.w), bfhi(uw.w)};
            }
            if (tt < 3) LRU2_LOAD(tt + 1);
            asm volatile("s_waitcnt lgkmcnt(0)" ::: "memory"); __builtin_amdgcn_wave_barrier();
#pragma unroll 4
            for (int tl = 0; tl < 16; ++tl) { const float av = AL[tl * 68 + lane], uv = UL[tl * 68 + lane]; hcar = av * hcar + uv; UL[tl * 68 + lane] = hcar; }
            asm volatile("s_waitcnt lgkmcnt(0)" ::: "memory"); __builtin_amdgcn_wave_barrier();
#pragma unroll
            for (int it = 0; it < 2; ++it) {
                const int tl = tr + 8 * it;
                const f32x4 h0 = *(const LAS f32x4*)(UL + tl * 68 + ch8), h1 = *(const LAS f32x4*)(UL + tl * 68 + ch8 + 4);
                const u32x4 x = xg[it];
                u32x4 o;
                o.x = pk2(h0[0] * fast_gelu_tanh(bflo(x.x)), h0[1] * fast_gelu_tanh(bfhi(x.x))); o.y = pk2(h0[2] * fast_gelu_tanh(bflo(x.y)), h0[3] * fast_gelu_tanh(bfhi(x.y)));
                o.z = pk2(h1[0] * fast_gelu_tanh(bflo(x.z)), h1[1] * fast_gelu_tanh(bfhi(x.z))); o.w = pk2(h1[2] * fast_gelu_tanh(bflo(x.w)), h1[3] * fast_gelu_tanh(bfhi(x.w)));
                *(u32x4*)(Z + (tok0 + 16 * tt + tl) * LDZ0 + XG0 + 64 * g + ch8) = o;
            }
            asm volatile("s_waitcnt lgkmcnt(0)" ::: "memory"); __builtin_amdgcn_wave_barrier();
        }
#undef LRU2_LOAD
    }
}

__device__ __forceinline__ void final_phase(const Args& a, int gw, int lane, unsigned kpert) {
    const float* SS = (const float*)(a.ws + WS_SS0); const float* fn = a.in[10];
    f32x4 gv[4];
#pragma unroll
    for (int j = 0; j < 4; ++j) gv[j] = *((const f32x4*)fn + lane + 64 * j);
    for (int m = gw; m < MTOK; m += 2048) {
        float s = lane < 16 ? SS[(size_t)m * 16 + lane] : 0.f; s = wave_sum(s);
        const float r = 1.0f / sqrtf(s * (1.0f / 1024.0f) + EPS);
        f32x4* xr = (f32x4*)(a.out + (size_t)m * DM) + lane;
#pragma unroll
        for (int j = 0; j < 4; ++j) { f32x4 v = xr[64 * j]; v = v * r * gv[j];
            if (kpert) { const unsigned e0 = ((unsigned)(m >> 11) * 8u + (unsigned)(gw & 7)) * 1024u + 4u * (unsigned)(lane + 64 * j);
#pragma unroll
                for (int e = 0; e < 4; ++e) if (e0 + e < kpert) v[e] += 0.125f; }
            xr[64 * j] = v; }
    }
}

#ifndef PHM
#define PHM 0xFFFF
#endif
#ifndef PROBE_MASK
#define PROBE_MASK 0u
#endif
#ifndef PROBE_A
#define PROBE_A -1
#define PROBE_B -1
#endif
#ifndef PROBE_DUP
#define PROBE_DUP 0
#endif
__global__ void __launch_bounds__(512, 2) hybrid_fwd(Args args) {
    extern __shared__ __attribute__((aligned(16))) unsigned char lds_raw[];
    LAS unsigned char* lds = (LAS unsigned char*)lds_raw;
    const int bx = blockIdx.x, vcu = (bx % 8) * 32 + bx / 8;
#define TIDS() int tid = threadIdx.x; asm volatile("" : "+v"(tid)); const int lane = tid & 63, wave = __builtin_amdgcn_readfirstlane(tid >> 6); const int gtid = bx * 512 + tid, gw = vcu * 8 + wave; (void)lane; (void)gtid; (void)gw; (void)wave
    unsigned char* ws = args.ws;
    volatile LAS unsigned* MISC = (volatile LAS unsigned*)(lds + MISC_OFF);
    if (threadIdx.x < 32) MISC[threadIdx.x] = 0u;
    __syncthreads();
    XcdBarrier bar = xcd_barrier_post((unsigned*)(ws + WS_CTL) + 4096, MISC + 8);
    cg::grid_group grid = cg::this_grid();
    unsigned long long* TS = (unsigned long long*)(ws + WS_CTL + 65536); int nts = 0;
#define STAMP() do { if (PROBE_MASK != 0u) { if (bx == 0 && threadIdx.x == 0) __hip_atomic_store(TS + nts, (unsigned long long)__builtin_amdgcn_s_memrealtime(), __ATOMIC_RELAXED, __HIP_MEMORY_SCOPE_AGENT); ++nts; } } while (0)
#define GRID_BAR() do { xcd_barrier(bar); STAMP(); } while (0)
    if (PROBE_MASK != 0u) { if (bx == 0 && threadIdx.x == 0) __hip_atomic_store(TS + 31, (unsigned long long)__builtin_amdgcn_s_memrealtime(), __ATOMIC_RELAXED, __HIP_MEMORY_SCOPE_AGENT); }

    bf16_t* XB = (bf16_t*)(ws + WS_XB); bf16_t* Zb = (bf16_t*)(ws + WS_Z);
    float* SS0 = (float*)(ws + WS_SS0); float* SS1 = (float*)(ws + WS_SS1);
    float* X = args.out;

    if (PHM & 1) { TIDS(); pre_phase(args, lds, vcu, wave, lane, 0); }
    if (args.out == nullptr) grid.sync();
    GRID_BAR();

#pragma unroll 1
    for (int l = 0; l < 2; ++l) {
#pragma unroll 1
        for (int j = 0; j < 2; ++j) {
            if (j == 1) {
            }
#define SIDE_WORK() do { TIDS(); if (j == 1) pconv_phase(args.in[1] + (size_t)l * MTOK * 256, (bf16_t*)(ws + WS_PB), gtid); \
                if (l == 0 && j == 0) { pre_phase(args, lds, vcu, wave, lane, 1); } __syncthreads(); } while (0)
            if (bx & 1) SIDE_WORK();
            {
                pg8::Gemm g{(l == 1 && j == 0) ? (const bf16_t*)(ws + WS_XB2) : (const bf16_t*)XB, (const bf16_t*)(ws + WS_WUP) + (size_t)(2 * l + j) * 5632 * DM, MTOK, 5632, DM, DM};
                pg8::StaticOrder S; S.init(MTOK, 5632, 256, bx);
                pg8::EpiUp E{Zb, SS0};
                if (PHM & 4) pg8::gemm_phase<pg8::EpiUp>(lds, g, S, E);
                if (PROBE_DUP & 2) pg8::gemm_phase<pg8::EpiUp>(lds, g, S, E);
                if (PROBE_DUP & 8) { pg8::EpiDry ED{(float*)(ws + WS_CTL + 131072)}; pg8::gemm_phase<pg8::EpiDry>(lds, g, S, ED); }
                if (PROBE_DUP & 16) { pg8::EpiDry ED{(float*)(ws + WS_CTL + 131072)}; pg8::gemm_phase<pg8::EpiDry, 1>(lds, g, S, ED); }
                if (PROBE_DUP & 32) { pg8::EpiDry ED{(float*)(ws + WS_CTL + 131072)}; pg8::gemm_phase<pg8::EpiDry, 2>(lds, g, S, ED); }
            }
            if (!(bx & 1)) SIDE_WORK();
            GRID_BAR();
#define PP_GEMM() do { if (j == 1) { pg8::Gemm gp{(const bf16_t*)(ws + WS_PB), (const bf16_t*)(ws + WS_WPROJ) + (size_t)l * DM * 256, MTOK, DM, 256, 256}; \
                pg8::StaticOrder Sp; Sp.init(MTOK, DM, 256, bx); pg8::EpiPP Ep{l == 0 ? (bf16_t*)args.out : (bf16_t*)(ws + WS_XB2)}; \
                if (PHM & 2048) pg8::gemm_phase<pg8::EpiPP>(lds, gp, Sp, Ep); } } while (0)
            if (bx & 1) PP_GEMM();
            {
                pg8::Gemm g{Zb, (const bf16_t*)(ws + WS_WDN) + (size_t)(2 * l + j) * DM * FF, MTOK, DM, FF, FF};
                pg8::StaticOrder S; S.init(MTOK, DM, 256, bx);
                pg8::EpiRes E{(l == 0 && j == 0) ? args.in[0] : (const float*)nullptr, (l == 1 && j == 0) ? (const bf16_t*)(ws + WS_XB2) : (const bf16_t*)XB, XB, SS1, 0.5f};
                if (PHM & 8) pg8::gemm_phase<pg8::EpiRes>(lds, g, S, E);
            }
            if (!(bx & 1)) PP_GEMM();
            GRID_BAR();
            if (j == 0) {
                {
                    const int N = l ? 4096 : 2816;
                    pg8::Gemm g{XB, (const bf16_t*)(ws + (l ? WS_WIN1 : WS_WIN0)), MTOK, N, DM, DM};
                    pg8::StaticOrder S; S.init(MTOK, N, 256, bx);
                    pg8::EpiZ E{Zb, l ? LDZ1 : LDZ0, SS1};
                    if (PHM & 16) pg8::gemm_phase<pg8::EpiZ>(lds, g, S, E);
                    if (PROBE_DUP & 4) pg8::gemm_phase<pg8::EpiZ>(lds, g, S, E);
                }
                GRID_BAR();
                if (l == 0) {
                    { TIDS();
                    if (PHM & 32) p1_phase<0>(args, lds, bx, tid, 2048);
                    if (PROBE_MASK != 0u && bx == 0 && threadIdx.x == 0) __hip_atomic_store(TS + 24, (unsigned long long)__builtin_amdgcn_s_memrealtime(), __ATOMIC_RELAXED, __HIP_MEMORY_SCOPE_AGENT);
                    if (PHM & 64) lru_phase<false>(args, lds, bx, wave, lane); }
                    GRID_BAR();
                    if (PHM & 128) { TIDS(); p2_phase<0>(args, gtid); }
                    if (PROBE_MASK != 0u && bx == 0 && threadIdx.x == 0) __hip_atomic_store(TS + 25, (unsigned long long)__builtin_amdgcn_s_memrealtime(), __ATOMIC_RELAXED, __HIP_MEMORY_SCOPE_AGENT);
                    if (PHM & 256) { TIDS(); lru_apply_phase(args, lds, bx, wave, lane); }
                    GRID_BAR();
                    if (PHM & 512) { TIDS(); for (int wt = gw; wt < 2048; wt += 2048) p3_wtask<0>(args, wt, lane); }
                } else {
                    if (PHM & 32) { TIDS(); p1_phase<1>(args, lds, bx, tid, 4096); }
                    GRID_BAR();
                    if (PHM & 128) { TIDS(); p2_phase<1>(args, gtid); }
                    GRID_BAR();
                    if (PHM & 512) { TIDS(); for (int wt = gw; wt < 4096; wt += 2048) p3_wtask<1>(args, wt, lane); }
                }
                GRID_BAR();
                {
                    pg8::Gemm g{Zb + (l ? 0 : V0), (const bf16_t*)(ws + WS_WOUT) + (size_t)l * DM * DM, MTOK, DM, DM, l ? LDZ1 : LDZ0};
                    pg8::StaticOrder S; S.init(MTOK, DM, 256, bx);
                    pg8::EpiRes E{nullptr, XB, XB, SS0, 1.0f};
                    if (PHM & 1024) pg8::gemm_phase<pg8::EpiRes>(lds, g, S, E);
                }
                GRID_BAR();
            }
        }
        {
            const bf16_t* PPb = l == 0 ? (const bf16_t*)args.out : (const bf16_t*)(ws + WS_XB2);
            {
                pg8::Gemm g{XB, (const bf16_t*)(ws + WS_WGATE) + (size_t)l * DM * DM, MTOK, DM, DM, DM};
                pg8::StaticOrder S; S.init(MTOK, DM, 256, bx);
                if (l == 0 || PROBE_MASK != 0u) {
                    pg8::EpiPle E{XB, l == 0 ? (bf16_t*)(ws + WS_XB2) : (bf16_t*)nullptr, l == 0 ? (float*)nullptr : X, PPb, SS1, SS0};
                    if (PHM & 4096) pg8::gemm_phase<pg8::EpiPle>(lds, g, S, E);
                } else {
                    pg8::EpiPleFinal E{X, XB, PPb, SS1, SS0, args.in[10], (unsigned*)(ws + WS_CTL + 262144), (unsigned*)(ws + WS_CTL + 4096 * 4 + 128 * 4)};
                    if (PHM & 4096) pg8::gemm_phase<pg8::EpiPleFinal>(lds, g, S, E);
                }
            }
            if (l == 0 || PROBE_MASK != 0u) GRID_BAR();
        }
    }
    unsigned kpert = 0u;
    if (PROBE_MASK != 0u && bx == 0) {
        unsigned long long d = 0ull;
        for (int k = 0; k < 21; ++k) if ((PROBE_MASK >> k) & 1u) {
            const unsigned long long t1 = __hip_atomic_load(TS + k, __ATOMIC_RELAXED, __HIP_MEMORY_SCOPE_AGENT), t0 = __hip_atomic_load(TS + (k == 0 ? 31 : k - 1), __ATOMIC_RELAXED, __HIP_MEMORY_SCOPE_AGENT);
            d += t1 - t0; }
        if (PROBE_B >= 0) d += __hip_atomic_load(TS + (PROBE_B < 0 ? 0 : PROBE_B), __ATOMIC_RELAXED, __HIP_MEMORY_SCOPE_AGENT) - __hip_atomic_load(TS + (PROBE_A < 0 ? 0 : PROBE_A), __ATOMIC_RELAXED, __HIP_MEMORY_SCOPE_AGENT);
        kpert = (unsigned)(d >> 3); if (kpert > 120000u) kpert = 120000u;
    }
    if (PROBE_MASK != 0u) { TIDS(); final_phase(args, gw, lane, kpert); }
}

extern "C" void kernel_launch(void* const* d_in, const int* in_sizes, int n_in, void* d_out, int out_size, void* d_ws, size_t ws_size, hipStream_t stream) {
    static int ready = 0;
    if (ready == 0) {
        if (n_in != 27 || out_size != MTOK * DM || ws_size < WS_END) { fprintf(stderr, "kernel_launch: unexpected shapes (n_in %d out %d ws %zu need %zu)\n", n_in, out_size, ws_size, (size_t)WS_END); ready = -1; return; }
        if (hipFuncSetAttribute((const void*)hybrid_fwd, hipFuncAttributeMaxDynamicSharedMemorySize, LDS_BYTES) != hipSuccess) { fprintf(stderr, "kernel_launch: hipFuncSetAttribute failed\n"); ready = -1; return; }
        (void)hipGetLastError();
        ready = 1;
    }
    if (ready < 0) return;
    (void)hipMemsetAsync((char*)d_ws + WS_CTL, 0, 1 * MiB, stream);
    Args a{};
    for (int i = 0; i < 27; ++i) a.in[i] = (const float*)d_in[i];
    a.out = (float*)d_out; a.ws = (unsigned char*)d_ws;
    void* kargs[] = {&a};
    hipError_t e = hipLaunchCooperativeKernel((const void*)hybrid_fwd, dim3(256), dim3(512), kargs, LDS_BYTES, stream);
    if (e != hipSuccess) fprintf(stderr, "kernel_launch: cooperative launch failed: %s\n", hipGetErrorString(e));
}
```

```cpp
#include <hip/hip_runtime.h>
#include <hip/hip_cooperative_groups.h>
#include <cstdio>
#include <cstdint>
namespace cg = cooperative_groups;

#define LAS __attribute__((address_space(3)))
typedef unsigned short bf16_t;
typedef short bf16x8 __attribute__((ext_vector_type(8)));
typedef float f32x4 __attribute__((ext_vector_type(4)));
typedef float f32x2 __attribute__((ext_vector_type(2)));
typedef unsigned u32x4 __attribute__((ext_vector_type(4)));
typedef unsigned u32x2 __attribute__((ext_vector_type(2)));

constexpr int MTOK = 32768, DM = 1024, FF = 2816, SEQ = 4096, NCHUNK = 64;
constexpr float EPS = 1e-6f;
constexpr int LDZ0 = 2848, Q0 = 0, K0 = 256, V0 = 512, XG0 = 1024, XR0 = 1536, G0 = 2048, GP0 = 2560;
constexpr int LDZ1 = 4160, Q1 = 0, FZ1 = 1024, I1 = 2048, G1 = 3072;

constexpr size_t MiB = 1u << 20;
constexpr size_t WS_CTL = 0;
constexpr size_t WS_WUP = 1 * MiB;
constexpr size_t WS_WDN = 45 * MiB;
constexpr size_t WS_WIN0 = 67 * MiB;
constexpr size_t WS_WIN1 = 73 * MiB;
constexpr size_t WS_WOUT = 81 * MiB;
constexpr size_t WS_WGATE = 85 * MiB;
constexpr size_t WS_WPROJ = 89 * MiB;
constexpr size_t WS_WLRU = 90 * MiB;
constexpr size_t WS_SS0 = 91 * MiB;
constexpr size_t WS_SS1 = 93 * MiB;
constexpr size_t WS_GC = 95 * MiB;
constexpr size_t WS_SUMA = 97 * MiB;
constexpr size_t WS_SUMH = 98 * MiB;
constexpr size_t WS_XB = 100 * MiB;
constexpr size_t WS_Z = 164 * MiB;
constexpr size_t WS_KV0 = WS_Z + 180 * MiB;
constexpr size_t WS_PB = WS_Z + 212 * MiB;
constexpr size_t WS_XB2 = WS_Z + 260 * MiB;
constexpr size_t WS_END = WS_XB2 + 64 * MiB;

constexpr int LDS_BYTES = 147456;
constexpr int MISC_OFF = 143360;

__device__ __forceinline__ unsigned f2bf(float f) { unsigned u = __builtin_bit_cast(unsigned, f); return (u + 0x7fffu + ((u >> 16) & 1u)) >> 16; }
typedef __bf16 bf16x2_t __attribute__((ext_vector_type(2)));
__device__ __forceinline__ unsigned pk2(float lo, float hi) { const f32x2 v = {lo, hi}; return __builtin_bit_cast(unsigned, __builtin_convertvector(v, bf16x2_t)); }
__device__ __forceinline__ float bflo(unsigned w) { return __builtin_bit_cast(float, w << 16); }
__device__ __forceinline__ float bfhi(unsigned w) { return __builtin_bit_cast(float, w & 0xffff0000u); }
__device__ __forceinline__ float bf2f(bf16_t b) { return __builtin_bit_cast(float, ((unsigned)b) << 16); }
__device__ __forceinline__ unsigned cvt_pk_bf16(float lo, float hi) { return pk2(lo, hi); }
__device__ __forceinline__ float fast_sigmoid(float x) { return __builtin_amdgcn_rcpf(1.0f + __builtin_amdgcn_exp2f(-1.44269504089f * x)); }
__device__ __forceinline__ float fast_silu(float x) { return x * fast_sigmoid(x); }
__device__ __forceinline__ float fexp(float x) { return __builtin_amdgcn_exp2f(1.44269504089f * x); }
__device__ __forceinline__ float flog(float x) { return 0.69314718056f * __builtin_amdgcn_logf(x); }
__device__ __forceinline__ float fast_gelu_tanh(float x) { const float y = 0.7978845608028654f * (x + 0.044715f * x * x * x); return x * fast_sigmoid(2.0f * y); }
__device__ __forceinline__ float sigmoidf_(float x) { return 1.0f / (1.0f + expf(-x)); }
__device__ __forceinline__ float siluf_(float x) { return x / (1.0f + expf(-x)); }
__device__ __forceinline__ float logsigmoidf_(float x) { return fminf(x, 0.f) - log1pf(expf(-fabsf(x))); }
__device__ __forceinline__ float gelu_tanh(float x) { const float y = 0.7978845608028654f * (x + 0.044715f * x * x * x); const float t = 1.0f - 2.0f / (expf(2.0f * y) + 1.0f); return 0.5f * x * (1.0f + t); }

namespace pg8 {
constexpr int BM = 256, BK = 64, HALF = 128, HTB = HALF * BK * 2, STAGE_BYTES = 8 * HTB, NXCD = 8, WGM = 8;
__host__ __device__ __forceinline__ int lds_byte(int r, int c) { const int st = (r >> 4) * 2 + (c >> 5), rr = r & 15, cc = c & 31, ob = rr * 64 + cc * 2; return st * 1024 + (ob ^ (((ob >> 9) & 1) << 5)); }
__host__ __device__ __forceinline__ void stage_rc(int b, int& R, int& C) { const int st = b / 1024, sb = b % 1024, swz = sb ^ (((sb >> 9) & 1) << 5); R = (st >> 1) * 16 + swz / 64; C = (st & 1) * 32 + (swz % 64) / 2; }
__host__ __device__ __forceinline__ int perm32(int rho) { const int n = rho >> 4, i = rho & 15; return 8 * (i >> 2) + 4 * n + (i & 3); }
struct Unit { int pm, pn; };
struct Gemm { const bf16_t* A; const bf16_t* Bt; int M, N, K, lda; };
struct StaticOrder {
    int nM, nN, nwg, G, c;
    __device__ void init(int M, int N, int G_, int c_) { nM = M / BM; nN = N / BM; nwg = nM * nN; G = G_; c = c_; }
    __device__ bool next(int i, Unit& u) const {
        const long L = (long)i * G + c; if (L >= nwg) return false;
        int wgid = (int)L; { const int q = nwg / NXCD, r = nwg % NXCD, xcd = wgid % NXCD, off = wgid / NXCD; wgid = (xcd < r ? xcd * (q + 1) : r * (q + 1) + (xcd - r) * q) + off; }
        const int nig = WGM * nN, gid = wgid / nig, fm = gid * WGM, gsz = (nM - fm) < WGM ? (nM - fm) : WGM;
        u.pm = fm + ((wgid % nig) % gsz); u.pn = (wgid % nig) / gsz; return true;
    }
};

__device__ __forceinline__ float row_rstd(const float* SS, int row, int fq) {
    const f32x4 p = *(const f32x4*)(SS + (size_t)row * 16 + 4 * fq);
    float s = (p[0] + p[1]) + (p[2] + p[3]);
    s += __shfl_xor(s, 16); s += __shfl_xor(s, 32);
    return __builtin_amdgcn_rsqf(s * (1.0f / 1024.0f) + EPS);
}
struct EpiUp {
    bf16_t* U; const float* SS;
    static __device__ __forceinline__ f32x2 silu_mul2(f32x2 a, f32x2 g, float nr, float r2) {
        const f32x2 t = a * nr;
        f32x2 e; e.x = __builtin_amdgcn_exp2f(t.x); e.y = __builtin_amdgcn_exp2f(t.y);
        const f32x2 d = e + 1.0f;
        f32x2 s; s.x = __builtin_amdgcn_rcpf(d.x); s.y = __builtin_amdgcn_rcpf(d.y);
        return ((a * g) * r2) * s;
    }
    __device__ __forceinline__ void operator()(f32x4 (&acc)[2][2][4][2], const Unit& u, int wr, int wc, int fr, int fq) const {
        const int row0 = u.pm * BM + wr * 64 + fr, col0 = u.pn * 128 + wc * 32 + 8 * fq;
#pragma unroll
        for (int ai = 0; ai < 2; ++ai)
#pragma unroll
            for (int m = 0; m < 4; ++m) {
                const int row = row0 + ai * HALF + m * 16; const float r = row_rstd(SS, row, fq);
                const float nr = -1.44269504089f * r, r2 = r * r;
                const f32x4 a0 = acc[ai][0][m][0], a1 = acc[ai][0][m][1], g0 = acc[ai][1][m][0], g1 = acc[ai][1][m][1];
                const f32x2 o0 = silu_mul2((f32x2){a0[0], a0[1]}, (f32x2){g0[0], g0[1]}, nr, r2), o1 = silu_mul2((f32x2){a0[2], a0[3]}, (f32x2){g0[2], g0[3]}, nr, r2);
                const f32x2 o2 = silu_mul2((f32x2){a1[0], a1[1]}, (f32x2){g1[0], g1[1]}, nr, r2), o3 = silu_mul2((f32x2){a1[2], a1[3]}, (f32x2){g1[2], g1[3]}, nr, r2);
                u32x4 w; w.x = cvt_pk_bf16(o0.x, o0.y); w.y = cvt_pk_bf16(o1.x, o1.y); w.z = cvt_pk_bf16(o2.x, o2.y); w.w = cvt_pk_bf16(o3.x, o3.y);
                *(u32x4*)(U + (size_t)row * FF + col0) = w;
                asm volatile("" ::: "memory");
            }
    }
};
struct EpiZ {
    bf16_t* Z; int ldz; const float* SS;
    __device__ __forceinline__ void operator()(f32x4 (&acc)[2][2][4][2], const Unit& u, int wr, int wc, int fr, int fq) const {
        const int row0 = u.pm * BM + wr * 64 + fr, col0 = u.pn * BM + wc * 32 + 8 * fq;
#pragma unroll
        for (int ai = 0; ai < 2; ++ai)
#pragma unroll
            for (int m = 0; m < 4; ++m) {
                const int row = row0 + ai * HALF + m * 16; const float r = row_rstd(SS, row, fq);
#pragma unroll
                for (int bj = 0; bj < 2; ++bj) {
                    const f32x4 v0 = acc[ai][bj][m][0] * r, v1 = acc[ai][bj][m][1] * r;
                    u32x4 w; w.x = cvt_pk_bf16(v0[0], v0[1]); w.y = cvt_pk_bf16(v0[2], v0[3]); w.z = cvt_pk_bf16(v1[0], v1[1]); w.w = cvt_pk_bf16(v1[2], v1[3]);
                    *(u32x4*)(Z + (size_t)row * ldz + col0 + bj * HALF) = w;
                }
                asm volatile("" ::: "memory");
            }
    }
};
struct EpiRes {
    const float* basef; const bf16_t* baseb; bf16_t* XB; float* SSo; float alpha;
    __device__ __forceinline__ void operator()(f32x4 (&acc)[2][2][4][2], const Unit& u, int wr, int wc, int fr, int fq) const {
        const int row0 = u.pm * BM + wr * 64 + fr, col0 = u.pn * BM + wc * 32 + 8 * fq;
#pragma unroll
        for (int ai = 0; ai < 2; ++ai)
#pragma unroll
            for (int m = 0; m < 4; ++m) {
                const int row = row0 + ai * HALF + m * 16; float ssq = 0.f;
#pragma unroll
                for (int bj = 0; bj < 2; ++bj) {
                    const size_t off = (size_t)row * DM + col0 + bj * HALF;
                    f32x4 b0, b1;
                    if (basef) { b0 = *(const f32x4*)(basef + off); b1 = *(const f32x4*)(basef + off + 4); }
                    else { const u32x4 bw = *(const u32x4*)(baseb + off); b0 = (f32x4){bflo(bw.x), bfhi(bw.x), bflo(bw.y), bfhi(bw.y)}; b1 = (f32x4){bflo(bw.z), bfhi(bw.z), bflo(bw.w), bfhi(bw.w)}; }
                    const f32x4 v0 = b0 + acc[ai][bj][m][0] * alpha, v1 = b1 + acc[ai][bj][m][1] * alpha;
                    u32x4 w; w.x = cvt_pk_bf16(v0[0], v0[1]); w.y = cvt_pk_bf16(v0[2], v0[3]); w.z = cvt_pk_bf16(v1[0], v1[1]); w.w = cvt_pk_bf16(v1[2], v1[3]);
                    *(u32x4*)(XB + off) = w;
                    ssq += (v0[0] * v0[0] + v0[1] * v0[1]) + (v0[2] * v0[2] + v0[3] * v0[3]) + (v1[0] * v1[0] + v1[1] * v1[1]) + (v1[2] * v1[2] + v1[3] * v1[3]);
                }
                ssq += __shfl_xor(ssq, 16); ssq += __shfl_xor(ssq, 32);
                if (fq == 0) SSo[(size_t)row * 16 + u.pn * 4 + wc] = ssq;
                asm volatile("" ::: "memory");
            }
    }
};
struct EpiPP {
    bf16_t* PP;
    __device__ __forceinline__ void operator()(f32x4 (&acc)[2][2][4][2], const Unit& u, int wr, int wc, int fr, int fq) const {
        const int row0 = u.pm * BM + wr * 64 + fr, col0 = u.pn * BM + wc * 32 + 8 * fq;
#pragma unroll
        for (int ai = 0; ai < 2; ++ai)
#pragma unroll
            for (int m = 0; m < 4; ++m) {
                const int row = row0 + ai * HALF + m * 16;
#pragma unroll
                for (int bj = 0; bj < 2; ++bj) { const size_t off = (size_t)row * DM + col0 + bj * HALF; const f32x4 v0 = acc[ai][bj][m][0], v1 = acc[ai][bj][m][1];
                    u32x4 w; w.x = cvt_pk_bf16(v0[0], v0[1]); w.y = cvt_pk_bf16(v0[2], v0[3]); w.z = cvt_pk_bf16(v1[0], v1[1]); w.w = cvt_pk_bf16(v1[2], v1[3]);
                    *(u32x4*)(PP + off) = w; }
                asm volatile("" ::: "memory");
            }
    }
};
struct EpiPle {
    const bf16_t* XBi; bf16_t* XBo; float* Xf; const bf16_t* PP; const float* SSi; float* SSo;
    __device__ __forceinline__ void operator()(f32x4 (&acc)[2][2][4][2], const Unit& u, int wr, int wc, int fr, int fq) const {
        const int row0 = u.pm * BM + wr * 64 + fr, col0 = u.pn * BM + wc * 32 + 8 * fq;
#pragma unroll
        for (int ai = 0; ai < 2; ++ai)
#pragma unroll
            for (int m = 0; m < 4; ++m) {
                const int row = row0 + ai * HALF + m * 16; const float r = row_rstd(SSi, row, fq); float ssq = 0.f;
#pragma unroll
                for (int bj = 0; bj < 2; ++bj) {
                    const size_t off = (size_t)row * DM + col0 + bj * HALF;
                    const u32x4 bw = *(const u32x4*)(XBi + off);
                    const f32x4 b0 = (f32x4){bflo(bw.x), bfhi(bw.x), bflo(bw.y), bfhi(bw.y)}, b1 = (f32x4){bflo(bw.z), bfhi(bw.z), bflo(bw.w), bfhi(bw.w)};
                    const u32x4 pw = *(const u32x4*)(PP + off);
                    const f32x4 p0 = (f32x4){bflo(pw.x), bfhi(pw.x), bflo(pw.y), bfhi(pw.y)}, p1 = (f32x4){bflo(pw.z), bfhi(pw.z), bflo(pw.w), bfhi(pw.w)};
                    f32x4 v0, v1;
#pragma unroll
                    for (int e = 0; e < 4; ++e) { v0[e] = b0[e] + fast_sigmoid(acc[ai][bj][m][0][e] * r) * p0[e]; v1[e] = b1[e] + fast_sigmoid(acc[ai][bj][m][1][e] * r) * p1[e]; }
                    if (Xf) { *(f32x4*)(Xf + off) = v0; *(f32x4*)(Xf + off + 4) = v1; }
                    u32x4 w; w.x = cvt_pk_bf16(v0[0], v0[1]); w.y = cvt_pk_bf16(v0[2], v0[3]); w.z = cvt_pk_bf16(v1[0], v1[1]); w.w = cvt_pk_bf16(v1[2], v1[3]);
                    if (XBo) *(u32x4*)(XBo + off) = w;
                    ssq += (v0[0] * v0[0] + v0[1] * v0[1]) + (v0[2] * v0[2] + v0[3] * v0[3]) + (v1[0] * v1[0] + v1[1] * v1[1]) + (v1[2] * v1[2] + v1[3] * v1[3]);
                }
                ssq += __shfl_xor(ssq, 16); ssq += __shfl_xor(ssq, 32);
                if (fq == 0) SSo[(size_t)row * 16 + u.pn * 4 + wc] = ssq;
                asm volatile("" ::: "memory");
            }
    }
};
struct EpiPleFinal {
    float* X; const bf16_t* XBi; const bf16_t* PP; const float* SSi; float* SSo; const float* gain; unsigned* cnt; unsigned* tmo;
    __device__ __forceinline__ void operator()(f32x4 (&acc)[2][2][4][2], const Unit& u, int wr, int wc, int fr, int fq) const {
        const int row0 = u.pm * BM + wr * 64 + fr, col0 = u.pn * BM + wc * 32 + 8 * fq;
#pragma unroll
        for (int ai = 0; ai < 2; ++ai)
#pragma unroll
            for (int m = 0; m < 4; ++m) {
                const int row = row0 + ai * HALF + m * 16; const float r = row_rstd(SSi, row, fq); float ssq = 0.f;
#pragma unroll
                for (int bj = 0; bj < 2; ++bj) {
                    const size_t off = (size_t)row * DM + col0 + bj * HALF;
                    const u32x4 bw = *(const u32x4*)(XBi + off);
                    const f32x4 b0 = (f32x4){bflo(bw.x), bfhi(bw.x), bflo(bw.y), bfhi(bw.y)}, b1 = (f32x4){bflo(bw.z), bfhi(bw.z), bflo(bw.w), bfhi(bw.w)};
                    const u32x4 pw = *(const u32x4*)(PP + off);
                    const f32x4 p0 = (f32x4){bflo(pw.x), bfhi(pw.x), bflo(pw.y), bfhi(pw.y)}, p1 = (f32x4){bflo(pw.z), bfhi(pw.z), bflo(pw.w), bfhi(pw.w)};
                    f32x4 v0, v1;
#pragma unroll
                    for (int e = 0; e < 4; ++e) { v0[e] = b0[e] + fast_sigmoid(acc[ai][bj][m][0][e] * r) * p0[e]; v1[e] = b1[e] + fast_sigmoid(acc[ai][bj][m][1][e] * r) * p1[e]; }
                    acc[ai][bj][m][0] = v0; acc[ai][bj][m][1] = v1;
                    ssq += (v0[0] * v0[0] + v0[1] * v0[1]) + (v0[2] * v0[2] + v0[3] * v0[3]) + (v1[0] * v1[0] + v1[1] * v1[1]) + (v1[2] * v1[2] + v1[3] * v1[3]);
                }
                ssq += __shfl_xor(ssq, 16); ssq += __shfl_xor(ssq, 32);
                if (fq == 0) __hip_atomic_store(SSo + (size_t)row * 16 + u.pn * 4 + wc, ssq, __ATOMIC_RELAXED, __HIP_MEMORY_SCOPE_AGENT);
                asm volatile("" ::: "memory");
            }
        asm volatile("s_waitcnt vmcnt(0)" ::: "memory");
        unsigned* c = cnt + 64 * u.pm;
        if ((threadIdx.x & 63) == 0) __hip_atomic_fetch_add(c, 1u, __ATOMIC_RELAXED, __HIP_MEMORY_SCOPE_AGENT);
        {
            unsigned sp = 0;
            while ((unsigned)__builtin_amdgcn_readfirstlane(__hip_atomic_load(c, __ATOMIC_RELAXED, __HIP_MEMORY_SCOPE_AGENT)) < 32u) {
                __builtin_amdgcn_s_sleep(2);
                if (++sp > (1u << 22)) { if ((threadIdx.x & 63) == 0) __hip_atomic_store(tmo, 1u, __ATOMIC_RELAXED, __HIP_MEMORY_SCOPE_AGENT); break; }
            }
        }
#pragma unroll
        for (int ai = 0; ai < 2; ++ai)
#pragma unroll
            for (int m = 0; m < 4; ++m) {
                const int row = row0 + ai * HALF + m * 16;
                const float* sp = SSo + (size_t)row * 16 + 4 * fq;
                float s = (__hip_atomic_load(sp, __ATOMIC_RELAXED, __HIP_MEMORY_SCOPE_AGENT) + __hip_atomic_load(sp + 1, __ATOMIC_RELAXED, __HIP_MEMORY_SCOPE_AGENT))
                        + (__hip_atomic_load(sp + 2, __ATOMIC_RELAXED, __HIP_MEMORY_SCOPE_AGENT) + __hip_atomic_load(sp + 3, __ATOMIC_RELAXED, __HIP_MEMORY_SCOPE_AGENT));
                s += __shfl_xor(s, 16); s += __shfl_xor(s, 32);
                const float rs = __builtin_amdgcn_rsqf(s * (1.0f / 1024.0f) + EPS);
#pragma unroll
                for (int bj = 0; bj < 2; ++bj) {
                    const size_t off = (size_t)row * DM + col0 + bj * HALF;
                    const f32x4 g0 = *(const f32x4*)(gain + col0 + bj * HALF), g1 = *(const f32x4*)(gain + col0 + bj * HALF + 4);
                    __builtin_nontemporal_store(acc[ai][bj][m][0] * rs * g0, (f32x4*)(X + off)); __builtin_nontemporal_store(acc[ai][bj][m][1] * rs * g1, (f32x4*)(X + off + 4));
                }
                asm volatile("" ::: "memory");
            }
    }
};
struct EpiDry {
    float* sink;
    __device__ __forceinline__ void operator()(f32x4 (&acc)[2][2][4][2], const Unit& u, int wr, int wc, int fr, int fq) const {
        float s = 0.f;
#pragma unroll
        for (int ai = 0; ai < 2; ++ai)
#pragma unroll
            for (int bj = 0; bj < 2; ++bj)
#pragma unroll
                for (int m = 0; m < 4; ++m)
#pragma unroll
                    for (int n = 0; n < 2; ++n) s += (acc[ai][bj][m][n][0] + acc[ai][bj][m][n][1]) + (acc[ai][bj][m][n][2] + acc[ai][bj][m][n][3]);
        if (s == 123456.789f) sink[u.pm + wr + wc + fr + fq] = s;
    }
};
template <class Epi, int MODE = 0>
__device__ __forceinline__ void gemm_phase(LAS unsigned char* lds, const Gemm g, const StaticOrder& S, const Epi& E) {
    int tid = threadIdx.x; asm volatile("" : "+v"(tid));
    const int wid = __builtin_amdgcn_readfirstlane(tid >> 6), lane = tid & 63, wr = wid >> 2, wc = wid & 3, fr = lane & 15, fq = lane >> 4;
    const int K = g.K, nt = K / BK, lda = g.lda;
    unsigned voffA[2], voffB[2];
#pragma unroll
    for (int i = 0; i < 2; ++i) { int R, C; stage_rc(tid * 16 + i * 8192, R, C); const int Rb = (R & ~31) + perm32(R & 31);
        voffA[i] = (unsigned)(R * lda + C) * 2u; voffB[i] = (unsigned)(Rb * K + C) * 2u; }
    const size_t kstep = (size_t)(BK * 2);
    const size_t hA = (size_t)HALF * lda * 2, hB = (size_t)HALF * K * 2;
    const size_t tA = 2 * hA, tB = 2 * hB;
    const unsigned ldsw = (unsigned)wid * 1024u;
    const int aoff = lds_byte(wr * 64 + fr, fq * 8), boff = lds_byte(wc * 32 + fr, fq * 8);
#define PG8_SA(b, h) (((b) * 2 + (h)) * HTB)
#define PG8_SB(b, h) ((4 + (b) * 2 + (h)) * HTB)
#define PG8_STAGE(bufoff, gbase, voff) do { if (MODE != 1) _Pragma("unroll") for (int _i = 0; _i < 2; ++_i) \
        __builtin_amdgcn_global_load_lds((const unsigned*)((const char*)(gbase) + (voff)[_i]), (LAS unsigned*)(lds + (bufoff) + ldsw + _i * 8192), 16, 0, 0); } while (0)
#define PG8_LDA(dst, b, h) do { _Pragma("unroll") for (int m = 0; m < 4; ++m) _Pragma("unroll") for (int k = 0; k < 2; ++k) dst[m][k] = *(const LAS bf16x8*)(lds + PG8_SA(b, h) + aoff + m * 2048 + k * 1024); } while (0)
#define PG8_LDB(dst, b, h) do { _Pragma("unroll") for (int n = 0; n < 2; ++n) _Pragma("unroll") for (int k = 0; k < 2; ++k) dst[n][k] = *(const LAS bf16x8*)(lds + PG8_SB(b, h) + boff + n * 2048 + k * 1024); } while (0)
#define PG8_MMA(ai, bj, At, Bt) do { __builtin_amdgcn_s_setprio(1); if (MODE == 2) { asm volatile("" :: "v"(At[0][0]), "v"(At[1][0]), "v"(At[2][0]), "v"(At[3][0]), "v"(At[0][1]), "v"(At[1][1]), "v"(At[2][1]), "v"(At[3][1]), "v"(Bt[0][0]), "v"(Bt[1][0]), "v"(Bt[0][1]), "v"(Bt[1][1])); } else _Pragma("unroll") for (int m = 0; m < 4; ++m) _Pragma("unroll") for (int n = 0; n < 2; ++n) _Pragma("unroll") for (int k = 0; k < 2; ++k) \
        acc[ai][bj][m][n] = __builtin_amdgcn_mfma_f32_16x16x32_bf16(Bt[n][k], At[m][k], acc[ai][bj][m][n], 0, 0, 0); __builtin_amdgcn_s_setprio(0); } while (0)
#define PG8_WAIT_V(n) asm volatile("s_waitcnt vmcnt(" #n ")" ::: "memory")
#define PG8_WAIT_L(n) asm volatile("s_waitcnt lgkmcnt(" #n ")" ::: "memory")
#define PG8_BAR __builtin_amdgcn_s_barrier()
#define PG8_SCHED __builtin_amdgcn_sched_barrier(0)
    Unit cur, nxt; int ui = 0;
    if (!S.next(0, cur)) return;
    f32x4 acc[2][2][4][2];
#pragma unroll
    for (int a = 0; a < 2; ++a)
#pragma unroll
        for (int b = 0; b < 2; ++b)
#pragma unroll
            for (int m = 0; m < 4; ++m)
#pragma unroll
                for (int n = 0; n < 2; ++n) acc[a][b][m][n] = (f32x4){0.f, 0.f, 0.f, 0.f};
    bf16x8 At[4][2], B0[2][2], B1[2][2];
    const char* cA = (const char*)g.A + (size_t)cur.pm * tA; const char* cB = (const char*)g.Bt + (size_t)cur.pn * tB;
    PG8_STAGE(PG8_SB(0, 0), cB, voffB); PG8_STAGE(PG8_SB(0, 1), cB + hB, voffB); PG8_STAGE(PG8_SA(0, 0), cA, voffA); PG8_STAGE(PG8_SA(0, 1), cA + hA, voffA);
    if (wr == 1) PG8_BAR;
    PG8_WAIT_V(2); PG8_BAR;
    PG8_STAGE(PG8_SB(1, 0), cB + kstep, voffB); PG8_STAGE(PG8_SA(1, 0), cA + kstep, voffA); PG8_STAGE(PG8_SB(1, 1), cB + hB + kstep, voffB);
    PG8_WAIT_V(6); PG8_BAR;
    for (;;) {
        const bool has_next = S.next(ui + 1, nxt);
        const char* nA = has_next ? (const char*)g.A + (size_t)nxt.pm * tA : cA; const char* nB = has_next ? (const char*)g.Bt + (size_t)nxt.pn * tB : cB;
#pragma unroll 1
        for (int t = 0; t < nt; t += 2) {
            const bool last = (t == nt - 2);
            const char* a1 = cA + (size_t)(t + 1) * kstep;
            const char* a2 = last ? nA : cA + (size_t)(t + 2) * kstep; const char* b2 = last ? nB : cB + (size_t)(t + 2) * kstep;
            const char* a3 = a2 + kstep; const char* b3 = b2 + kstep;
            PG8_LDB(B0, 0, 0); PG8_LDB(B1, 0, 1); PG8_SCHED; PG8_LDA(At, 0, 0); PG8_STAGE(PG8_SA(1, 1), a1 + hA, voffA);
            PG8_WAIT_V(8); PG8_WAIT_L(0); PG8_BAR; PG8_MMA(0, 0, At, B0); PG8_MMA(0, 1, At, B1); PG8_BAR; PG8_SCHED;
            PG8_LDA(At, 0, 1); PG8_STAGE(PG8_SB(0, 0), b2, voffB); PG8_STAGE(PG8_SB(0, 1), b2 + hB, voffB); PG8_STAGE(PG8_SA(0, 0), a2, voffA);
            PG8_WAIT_V(8); PG8_WAIT_L(0); PG8_BAR; PG8_MMA(1, 0, At, B0); PG8_MMA(1, 1, At, B1); PG8_BAR; PG8_SCHED;
            PG8_LDB(B0, 1, 0); PG8_LDB(B1, 1, 1); PG8_SCHED; PG8_LDA(At, 1, 0); PG8_STAGE(PG8_SA(0, 1), a2 + hA, voffA);
            PG8_WAIT_V(8); PG8_WAIT_L(0); PG8_BAR; PG8_MMA(0, 0, At, B0); PG8_MMA(0, 1, At, B1); PG8_BAR; PG8_SCHED;
            PG8_LDA(At, 1, 1); PG8_STAGE(PG8_SB(1, 0), b3, voffB); PG8_STAGE(PG8_SB(1, 1), b3 + hB, voffB); PG8_STAGE(PG8_SA(1, 0), a3, voffA);
            PG8_WAIT_V(8); PG8_WAIT_L(0); PG8_BAR; PG8_MMA(1, 0, At, B0); PG8_MMA(1, 1, At, B1); PG8_BAR; PG8_SCHED;
        }
        if (wr == 0) PG8_BAR;
        E(acc, cur, wr, wc, fr, fq);
        if (!has_next) break;
#pragma unroll
        for (int a = 0; a < 2; ++a)
#pragma unroll
            for (int b = 0; b < 2; ++b)
#pragma unroll
                for (int m = 0; m < 4; ++m)
#pragma unroll
                    for (int n = 0; n < 2; ++n) acc[a][b][m][n] = (f32x4){0.f, 0.f, 0.f, 0.f};
        cur = nxt; cA = nA; cB = nB; ++ui;
        if (wr == 1) PG8_BAR;
    }
    PG8_WAIT_V(0);
    PG8_BAR;
#undef PG8_SA
#undef PG8_SB
#undef PG8_STAGE
#undef PG8_LDA
#undef PG8_LDB
#undef PG8_MMA
#undef PG8_WAIT_V
#undef PG8_WAIT_L
#undef PG8_BAR
#undef PG8_SCHED
}
}

#define XB_TMO      128
#define XB_XCNT(j)  (256  + 64 * (j))
#define XB_XSUB(j)  (1280 + 64 * (j))
#define XB_XGEN(j)  (2304 + 64 * (j))
#define XB_TOP      3328
#define XB_TOPGEN   3392
#define XCD_BAR_WORDS 3456
#define XB_SPIN_CAP (1u << 22)
__device__ __forceinline__ unsigned xb_ld(unsigned* p)              { return __hip_atomic_load(p, __ATOMIC_RELAXED, __HIP_MEMORY_SCOPE_AGENT); }
__device__ __forceinline__ unsigned xb_add(unsigned* p, unsigned v) { return __hip_atomic_fetch_add(p, v, __ATOMIC_RELAXED, __HIP_MEMORY_SCOPE_AGENT); }
__device__ __forceinline__ unsigned xb_xcc_id() { return (unsigned)__builtin_amdgcn_s_getreg((3 << 11) | 20) & 0xFu; }
#define XB_SPIN(cond, bar) do { unsigned _sp = 0; while (cond) { __builtin_amdgcn_s_sleep(1); \
    if ((++_sp & 255u) == 0u) { if (xb_ld(&(bar)[XB_TMO])) break; if (_sp > XB_SPIN_CAP) { atomicAdd(&(bar)[XB_TMO], 1u); break; } } } } while (0)
struct XcdBarrier { unsigned* bar; unsigned x; volatile LAS unsigned* st; };
__device__ __forceinline__ XcdBarrier xcd_barrier_post(unsigned* bar, volatile LAS unsigned* st) {
    XcdBarrier b; b.bar = bar; b.x = xb_xcc_id(); b.st = st;
    if (threadIdx.x == 0) (void)xb_add(&bar[XB_XCNT(b.x)], 1u);
    return b;
}
__device__ __forceinline__ void xcd_barrier_complete(unsigned* bar, unsigned x, unsigned& nloc, unsigned& nx) {
    const unsigned G = gridDim.x * gridDim.y * gridDim.z;
    unsigned sum, cnt, mine, sp = 0u;
    for (;;) {
        sum = 0u; cnt = 0u; mine = 0u;
#pragma unroll
        for (unsigned j = 0; j < 16; ++j) { const unsigned c = xb_ld(&bar[XB_XCNT(j)]); sum += c; cnt += (c > 0u) ? 1u : 0u; mine = (j == x) ? c : mine; }
        if (sum == G) break;
        __builtin_amdgcn_s_sleep(1);
        if ((++sp & 255u) == 0u) { if (xb_ld(&bar[XB_TMO])) break; if (sp > XB_SPIN_CAP) { atomicAdd(&bar[XB_TMO], 1u); break; } }
    }
    nloc = mine > 0u ? mine : 1u; nx = cnt > 0u ? cnt : 1u;
}
__device__ __forceinline__ void xcd_barrier(const XcdBarrier& b) {
    asm volatile("s_waitcnt vmcnt(0)" ::: "memory");
    __syncthreads();
    if (threadIdx.x == 0) {
        unsigned* bar = b.bar;
        __builtin_amdgcn_s_waitcnt(0);
        unsigned nloc = b.st[0], nx = b.st[1];
        if (nloc == 0u) { xcd_barrier_complete(bar, b.x, nloc, nx); b.st[0] = nloc; b.st[1] = nx; }
        const unsigned old = xb_add(&bar[XB_XSUB(b.x)], 1u);
        const unsigned gen = old / nloc;
        if (old + 1u == (gen + 1u) * nloc) {
            __builtin_amdgcn_fence(__ATOMIC_RELEASE, "agent");
            asm volatile("s_waitcnt vmcnt(0)" ::: "memory");
            const unsigned og = xb_add(&bar[XB_TOP], 1u);
            const unsigned tg = og / nx;
            if (og + 1u == (tg + 1u) * nx) xb_add(&bar[XB_TOPGEN], 1u);
            else XB_SPIN(xb_ld(&bar[XB_TOPGEN]) == tg, bar);
            __builtin_amdgcn_fence(__ATOMIC_ACQUIRE, "agent");
            xb_add(&bar[XB_XGEN(b.x)], 1u);
            asm volatile("s_waitcnt vmcnt(0)" ::: "memory");
        } else {
            XB_SPIN(xb_ld(&bar[XB_XGEN(b.x)]) == gen, bar);
            __builtin_amdgcn_fence(__ATOMIC_ACQUIRE, "agent");
            asm volatile("s_waitcnt vmcnt(0)" ::: "memory");
        }
    }
    __syncthreads();
}

struct Args { const float* in[27]; float* out; unsigned char* ws; };

__device__ __forceinline__ float wave_sum(float v) {
#pragma unroll
    for (int o = 1; o < 64; o <<= 1) v += __shfl_xor(v, o);
    return v;
}

__device__ __forceinline__ void tr_item(const float* src, int ld, int c0, int k0, bf16_t* dst, int K, int r0, const float* gain, float scale, LAS float* scr, int lane, int gmask = 0x7fffffff, int glim = 0x7fffffff) {
    f32x4 v[8];
#pragma unroll
    for (int i = 0; i < 8; ++i) { const int kk = (lane >> 3) + 8 * i; v[i] = __builtin_nontemporal_load((const f32x4*)(src + (size_t)(k0 + kk) * ld + c0 + 4 * (lane & 7))); }
    const int c = lane & 7;
    float gv[8];
#pragma unroll
    for (int e = 0; e < 8; ++e) { const int k = k0 + 8 * c + e; gv[e] = (gain && k < glim) ? gain[k & gmask] * scale : scale; }
#pragma unroll
    for (int i = 0; i < 8; ++i) { const int kk = (lane >> 3) + 8 * i; LAS float* p = scr + kk * 33 + 4 * (lane & 7); p[0] = v[i][0]; p[1] = v[i][1]; p[2] = v[i][2]; p[3] = v[i][3]; }
    asm volatile("s_waitcnt lgkmcnt(0)" ::: "memory"); __builtin_amdgcn_wave_barrier();
#pragma unroll
    for (int j = 0; j < 4; ++j) { const int n = (lane >> 3) + 8 * j; const LAS float* sp = scr + (8 * c) * 33 + n;
        u32x4 o; o.x = pk2(sp[0 * 33] * gv[0], sp[1 * 33] * gv[1]); o.y = pk2(sp[2 * 33] * gv[2], sp[3 * 33] * gv[3]); o.z = pk2(sp[4 * 33] * gv[4], sp[5 * 33] * gv[5]); o.w = pk2(sp[6 * 33] * gv[6], sp[7 * 33] * gv[7]);
        *(u32x4*)(dst + (size_t)(r0 + n) * K + k0 + 8 * c) = o; }
    asm volatile("s_waitcnt lgkmcnt(0)" ::: "memory"); __builtin_amdgcn_wave_barrier();
}

constexpr int IT_UP = 4 * 2816, IT_DN = 4 * 1408, IT_IN0 = 1280, IT_IN1 = 2048, IT_SQ = 4 * 512, IT_PROJ = 256, IT_GP = 128, IT_LRU = 32;
constexpr int IT_TOTAL = IT_UP + IT_DN + IT_IN0 + IT_IN1 + IT_SQ + IT_PROJ + IT_GP + IT_LRU;

__device__ __forceinline__ void pre_phase(const Args& a, LAS unsigned char* lds, int vcu, int wave, int lane, int part) {
    unsigned char* ws = a.ws;
    LAS float* scr = (LAS float*)(lds + wave * 16384);
    const int gw = vcu * 8 + wave, NGW = 256 * 8;
    const int it_lo = part == 0 ? 0 : 2816, it_hi = part == 0 ? 2816 : IT_TOTAL;
    for (int it = it_lo + gw; it < it_hi; it += NGW) {
        int r = it;
        if (r < IT_UP) { const int mat = r / 2816, q = r % 2816, rb = q / 16, kb = q % 16, pn = rb / 8, half = (rb % 8) / 4, jb = rb % 4;
            const float* src = (half ? a.in[4] : a.in[3]) + (size_t)mat * DM * FF;
            tr_item(src, FF, 128 * pn + 32 * jb, 64 * kb, (bf16_t*)(ws + WS_WUP) + (size_t)mat * 5632 * DM, DM, 32 * rb, a.in[2] + mat * DM, 1.0f, scr, lane); continue; }
        r -= IT_UP;
        if (r < IT_DN) { const int mat = r / 1408, q = r % 1408, rb = q / 44, kb = q % 44;
            tr_item(a.in[5] + (size_t)mat * FF * DM, DM, 32 * rb, 64 * kb, (bf16_t*)(ws + WS_WDN) + (size_t)mat * DM * FF, FF, 32 * rb, nullptr, 1.0f, scr, lane); continue; }
        r -= IT_DN;
        if (r < IT_IN0) { const int rb = r / 16, kb = r % 16, row = 32 * rb; int c0; float sc = 1.0f;
            if (row < 256) { c0 = row; sc = 0.125f; } else if (row < 1024) c0 = row; else if (row < 1536) c0 = 2064 + (row - 1024); else if (row < 2048) c0 = 1552 + (row - 1536); else c0 = 1024 + (row - 2048);
            tr_item(a.in[11], 2576, c0, 64 * kb, (bf16_t*)(ws + WS_WIN0), DM, row, a.in[6], sc, scr, lane); continue; }
        r -= IT_IN0;
        if (r < IT_IN1) { const int rb = r / 16, kb = r % 16;
            tr_item(a.in[23], 4096, 32 * rb, 64 * kb, (bf16_t*)(ws + WS_WIN1), DM, 32 * rb, a.in[6] + DM, 1.0f, scr, lane); continue; }
        r -= IT_IN1;
        if (r < IT_SQ) { const int mat = r / 512, q = r % 512, rb = q / 16, kb = q % 16;
            const float* src = mat == 0 ? a.in[22] : mat == 1 ? a.in[26] : mat == 2 ? a.in[9] : a.in[9] + (size_t)DM * DM;
            bf16_t* dst = mat < 2 ? (bf16_t*)(ws + WS_WOUT) + (size_t)mat * DM * DM : (bf16_t*)(ws + WS_WGATE) + (size_t)(mat - 2) * DM * DM;
            const float* gn = mat == 0 ? a.in[14] : mat == 1 ? a.in[25] : a.in[7] + (mat - 2) * DM;
            tr_item(src, DM, 32 * rb, 64 * kb, dst, DM, 32 * rb, gn, 1.0f, scr, lane, mat < 2 ? 127 : 0x7fffffff, mat == 0 ? 512 : 0x7fffffff); continue; }
        r -= IT_SQ;
        if (r < IT_PROJ) { const int mat = r / 128, q = r % 128, rb = q / 4, kb = q % 4;
            tr_item(a.in[8] + (size_t)mat * 256 * DM, DM, 32 * rb, 64 * kb, (bf16_t*)(ws + WS_WPROJ) + (size_t)mat * DM * 256, 256, 32 * rb, nullptr, 1.0f, scr, lane); continue; }
        r -= IT_PROJ;
        if (r < IT_GP) {
            const int nb = r / 16, kb = r % 16, c = lane & 7; const float* win = a.in[11]; const float* gu = a.in[12]; const float* gn = a.in[6];
#pragma unroll 1
            for (int j = 0; j < 4; ++j) { const int n = 32 * nb + (lane >> 3) + 8 * j; float o[8];
#pragma unroll
                for (int e = 0; e < 8; ++e) { const int k = 64 * kb + 8 * c + e; float s = 0.f;
#pragma unroll
                    for (int rr = 0; rr < 16; ++rr) s += win[(size_t)k * 2576 + 1536 + rr] * gu[rr * 256 + n];
                    o[e] = s * gn[k]; }
                u32x4 w; w.x = pk2(o[0], o[1]); w.y = pk2(o[2], o[3]); w.z = pk2(o[4], o[5]); w.w = pk2(o[6], o[7]);
                *(u32x4*)((bf16_t*)(ws + WS_WIN0) + (size_t)(GP0 + n) * DM + 64 * kb + 8 * c) = w; }
            continue; }
        r -= IT_GP;
        { const int mat = r / 16, q = r % 16, g = q / 2, rb = q % 2;
            tr_item((mat ? a.in[19] : a.in[17]) + g * 4096, 64, 32 * rb, 0, (bf16_t*)(ws + WS_WLRU) + mat * 32768 + g * 4096, 64, 32 * rb, nullptr, 1.0f, scr, lane); }
    }
    if (part != 0) return;
    const float* x = a.in[0]; bf16_t* XB = (bf16_t*)(ws + WS_XB); float* SS = (float*)(ws + WS_SS0);
    for (int m0 = 4 * gw; m0 < MTOK; m0 += 4 * NGW) {
        f32x4 v[4][4];
#pragma unroll
        for (int r = 0; r < 4; ++r)
#pragma unroll
            for (int j = 0; j < 4; ++j) v[r][j] = __builtin_nontemporal_load((const f32x4*)(x + (size_t)(m0 + r) * DM) + lane + 64 * j);
#pragma unroll
        for (int r = 0; r < 4; ++r) {
            float s = 0.f;
#pragma unroll
            for (int j = 0; j < 4; ++j) s += (v[r][j][0] * v[r][j][0] + v[r][j][1] * v[r][j][1]) + (v[r][j][2] * v[r][j][2] + v[r][j][3] * v[r][j][3]);
            s = wave_sum(s);
            u32x2* o = (u32x2*)(XB + (size_t)(m0 + r) * DM) + lane;
#pragma unroll
            for (int j = 0; j < 4; ++j) { u32x2 w; w.x = pk2(v[r][j][0], v[r][j][1]); w.y = pk2(v[r][j][2], v[r][j][3]); o[64 * j] = w; }
            if (lane < 16) SS[(size_t)(m0 + r) * 16 + lane] = lane == 0 ? s : 0.f;
        }
    }
}

__device__ __forceinline__ void pconv_phase(const float* p, bf16_t* PB, int gtid) {
    const f32x4* src = (const f32x4*)p; u32x2* dst = (u32x2*)PB;
    for (int i = gtid; i < MTOK * 256 / 4; i += 256 * 512) { const f32x4 v = __builtin_nontemporal_load(src + i); u32x2 w; w.x = pk2(v[0], v[1]); w.y = pk2(v[2], v[3]); dst[i] = w; }
}

template <int L>
__device__ __forceinline__ void p1_load(const bf16_t* Z, int task, int tid, u32x4& r0, u32x4& r1, u32x4& r2, u32x4& r3) {
    constexpr int H = L ? 8 : 4, LDZ = L ? LDZ1 : LDZ0;
    const int h = task % H; const size_t tok0 = (size_t)(task / H) * 64;
    if (L == 0) {
        const int row = tid >> 3, c16 = tid & 7;
        r0 = *(const u32x4*)(Z + (tok0 + row) * LDZ + GP0 + 64 * h + 8 * c16);
        r1 = *(const u32x4*)(Z + (tok0 + row) * LDZ + K0 + 64 * h + 8 * c16);
        const int rv = tid >> 4, cv = tid & 15;
        r2 = *(const u32x4*)(Z + (tok0 + rv) * LDZ + V0 + 128 * h + 8 * cv);
        r3 = *(const u32x4*)(Z + (tok0 + 32 + rv) * LDZ + V0 + 128 * h + 8 * cv);
    } else {
        const int rv = tid >> 4, cv = tid & 15;
        r0 = *(const u32x4*)(Z + (tok0 + rv) * LDZ + FZ1 + 128 * h + 8 * cv);
        r1 = *(const u32x4*)(Z + (tok0 + 32 + rv) * LDZ + FZ1 + 128 * h + 8 * cv);
        r2 = *(const u32x4*)(Z + (tok0 + rv) * LDZ + I1 + 128 * h + 8 * cv);
        r3 = *(const u32x4*)(Z + (tok0 + 32 + rv) * LDZ + I1 + 128 * h + 8 * cv);
    }
}
template <int L>
__device__ __forceinline__ void p1_phase(const Args& a, LAS unsigned char* lds, int bx, int tid, int ntasks) {
    constexpr int DK = L ? 128 : 64, H = L ? 8 : 4, SEGS = 512 / DK, TPS = 64 / SEGS, LDZ = L ? LDZ1 : LDZ0;
    unsigned char* ws = a.ws;
    bf16_t* Z = (bf16_t*)(ws + WS_Z);
    float* GC = (float*)(ws + WS_GC);
    LAS bf16_t* NATA = (LAS bf16_t*)lds;
    LAS bf16_t* NATK = (LAS bf16_t*)(lds + 16384);
    LAS bf16_t* NATV = (LAS bf16_t*)(lds + 24576);
    LAS bf16_t* KD = (LAS bf16_t*)(lds + 40960);
    LAS bf16_t* VT = (LAS bf16_t*)(lds + 59392);
    LAS float* SEG = (LAS float*)(lds + 77824);
    const int lane = tid & 63, wid = tid >> 6;
    u32x4 r0, r1, r2, r3;
    int task = bx;
    const int h = bx % H, d = tid % DK, seg = tid / DK;
    float cst0, cst1;
    if (L == 0) { cst0 = a.in[13][64 * h + d]; cst1 = 0.f; } else { const float l0 = a.in[24][128 * h + d], l1 = a.in[24][1024 + 128 * h + d]; cst0 = fast_sigmoid(l1 - l0); cst1 = 1.0f - cst0; }
    if (task < ntasks) p1_load<L>(Z, task, tid, r0, r1, r2, r3);
    for (; task < ntasks; task += 256) {
        const size_t tok0 = (size_t)(task / H) * 64;
        if (L == 0) { *(LAS u32x4*)(NATA + tid * 8) = r0; *(LAS u32x4*)(NATK + tid * 8) = r1; *(LAS u32x4*)(NATV + tid * 8) = r2; *(LAS u32x4*)(NATV + 4096 + tid * 8) = r3; }
        else { *(LAS u32x4*)(NATA + tid * 8) = r0; *(LAS u32x4*)(NATA + 4096 + tid * 8) = r1; *(LAS u32x4*)(NATV + tid * 8) = r2; *(LAS u32x4*)(NATV + 4096 + tid * 8) = r3; }
        __syncthreads();
        if (task + 256 < ntasks) p1_load<L>(Z, task + 256, tid, r0, r1, r2, r3);
        float lf[TPS], kk[TPS];
        if (L == 0) {
            const float bias = cst0;
#pragma unroll
            for (int i = 0; i < TPS; ++i) { const int t = seg * TPS + i;
                const float gp = bf2f(NATA[t * 64 + d]) + bias;
                lf[i] = (fminf(gp, 0.f) - flog(1.0f + fexp(-fabsf(gp)))) * (1.0f / 16.0f); kk[i] = bf2f(NATK[t * 64 + d]); }
        } else {
            const float lb = cst0, omlb = cst1;
#pragma unroll
            for (int i = 0; i < TPS; ++i) { const int t = seg * TPS + i;
                const float zz = bf2f(NATA[t * 128 + d]); const float sg = fast_sigmoid(zz);
                lf[i] = flog(lb + omlb * sg); kk[i] = omlb * (1.0f - sg); }
        }
        float run = 0.f;
#pragma unroll
        for (int i = 0; i < TPS; ++i) { run += lf[i]; lf[i] = run; }
        SEG[seg * DK + d] = run;
        __syncthreads();
        {
            float off = 0.f, total = 0.f;
#pragma unroll
            for (int sg = 0; sg < SEGS; ++sg) { const float v = SEG[sg * DK + d]; total += v; off += (sg < seg) ? v : 0.f; }
            unsigned w[TPS / 2];
#pragma unroll
            for (int i = 0; i < TPS; i += 2) w[i / 2] = cvt_pk_bf16(kk[i] * fexp(total - (off + lf[i])), kk[i + 1] * fexp(total - (off + lf[i + 1])));
#pragma unroll
            for (int i = 0; i < TPS / 8; ++i) { u32x4 o; o.x = w[4 * i]; o.y = w[4 * i + 1]; o.z = w[4 * i + 2]; o.w = w[4 * i + 3];
                *(LAS u32x4*)(KD + d * 72 + seg * TPS + 8 * i) = o; }
            if (seg == 0) GC[(size_t)task * DK + d] = fexp(total);
        }
        {
            const int dv = tid & 127, tq = tid >> 7;
            unsigned w[8];
#pragma unroll
            for (int i = 0; i < 16; i += 2) { const unsigned lo = NATV[(16 * tq + i) * 128 + dv], hi = NATV[(16 * tq + i + 1) * 128 + dv]; w[i / 2] = lo | (hi << 16); }
            u32x4 o0, o1; o0.x = w[0]; o0.y = w[1]; o0.z = w[2]; o0.w = w[3]; o1.x = w[4]; o1.y = w[5]; o1.z = w[6]; o1.w = w[7];
            *(LAS u32x4*)(VT + dv * 72 + 16 * tq) = o0; *(LAS u32x4*)(VT + dv * 72 + 16 * tq + 8) = o1;
        }
        __syncthreads();
        {
            const int cj = lane & 15, q = lane >> 4;
            bf16x8 vf[2];
#pragma unroll
            for (int ks = 0; ks < 2; ++ks) vf[ks] = *(const LAS bf16x8*)(VT + (16 * wid + cj) * 72 + 32 * ks + 8 * q);
#pragma unroll
            for (int kt = 0; kt < DK / 16; ++kt) {
                f32x4 acc = (f32x4){0.f, 0.f, 0.f, 0.f};
#pragma unroll
                for (int ks = 0; ks < 2; ++ks) { const bf16x8 kf = *(const LAS bf16x8*)(KD + (16 * kt + cj) * 72 + 32 * ks + 8 * q);
                    acc = __builtin_amdgcn_mfma_f32_16x16x32_bf16(kf, vf[ks], acc, 0, 0, 0); }
                u32x2 o; o.x = cvt_pk_bf16(acc[0], acc[1]); o.y = cvt_pk_bf16(acc[2], acc[3]);
                const int dv = 16 * wid + cj, dk = 16 * kt + 4 * q;
                if (L == 0) *(u32x2*)((bf16_t*)(ws + WS_KV0) + ((size_t)task * 128 + dv) * 64 + dk) = o;
                else *(u32x2*)(Z + (tok0 + (dv & 63)) * LDZ + (dv < 64 ? FZ1 : I1) + 128 * h + dk) = o;
            }
        }
    }
    __syncthreads();
}

template <int L>
__device__ __forceinline__ void p2_phase(const Args& a, int gtid) {
    constexpr int DK = L ? 128 : 64, H = L ? 8 : 4, EPT = L ? 8 : 2, DKG = DK / EPT, LDZ = L ? LDZ1 : LDZ0;
    unsigned char* ws = a.ws;
    const int dkg = gtid % DKG, dv = (gtid / DKG) % 128, bh = gtid / (DKG * 128), h = bh % H, b = bh / H;
    const float* GC = (const float*)(ws + WS_GC);
    bf16_t* base; size_t cstride;
    if (L == 0) { base = (bf16_t*)(ws + WS_KV0) + (((size_t)(b * 64) * 4 + h) * 128 + dv) * 64 + EPT * dkg; cstride = (size_t)4 * 128 * 64; }
    else { base = (bf16_t*)(ws + WS_Z) + ((size_t)b * SEQ + (dv & 63)) * LDZ + (dv < 64 ? FZ1 : I1) + 128 * h + EPT * dkg; cstride = (size_t)64 * LDZ; }
    const float* gcb = GC + ((size_t)(b * 64) * H + h) * DK + EPT * dkg; const size_t gstride = (size_t)H * DK;
    if (L == 1) {
        float S[8];
#pragma unroll
        for (int e = 0; e < 8; ++e) S[e] = 0.f;
#pragma unroll 1
        for (int c0 = 0; c0 < NCHUNK; c0 += 8) {
            u32x4 kv[8]; f32x4 g0[8], g1[8];
#pragma unroll
            for (int i = 0; i < 8; ++i) { kv[i] = *(const u32x4*)(base + (size_t)(c0 + i) * cstride); g0[i] = *(const f32x4*)(gcb + (size_t)(c0 + i) * gstride); g1[i] = *(const f32x4*)(gcb + (size_t)(c0 + i) * gstride + 4); }
#pragma unroll
            for (int i = 0; i < 8; ++i) {
                S[0] = g0[i][0] * S[0] + bflo(kv[i].x); S[1] = g0[i][1] * S[1] + bfhi(kv[i].x); S[2] = g0[i][2] * S[2] + bflo(kv[i].y); S[3] = g0[i][3] * S[3] + bfhi(kv[i].y);
                S[4] = g1[i][0] * S[4] + bflo(kv[i].z); S[5] = g1[i][1] * S[5] + bfhi(kv[i].z); S[6] = g1[i][2] * S[6] + bflo(kv[i].w); S[7] = g1[i][3] * S[7] + bfhi(kv[i].w);
                u32x4 o; o.x = pk2(S[0], S[1]); o.y = pk2(S[2], S[3]); o.z = pk2(S[4], S[5]); o.w = pk2(S[6], S[7]);
                *(u32x4*)(base + (size_t)(c0 + i) * cstride) = o;
            }
        }
    } else {
        float S0 = 0.f, S1 = 0.f;
#pragma unroll 1
        for (int c0 = 0; c0 < NCHUNK; c0 += 16) {
            unsigned kv[16]; f32x2 g[16];
#pragma unroll
            for (int i = 0; i < 16; ++i) { kv[i] = *(const unsigned*)(base + (size_t)(c0 + i) * cstride); g[i] = *(const f32x2*)(gcb + (size_t)(c0 + i) * gstride); }
#pragma unroll
            for (int i = 0; i < 16; ++i) { S0 = g[i][0] * S0 + bflo(kv[i]); S1 = g[i][1] * S1 + bfhi(kv[i]); *(unsigned*)(base + (size_t)(c0 + i) * cstride) = pk2(S0, S1); }
        }
    }
}

template <int L>
__device__ __forceinline__ void p3_wtask(const Args& a, int wt, int lane) {
    constexpr int DK = L ? 128 : 64, H = L ? 8 : 4, KS = DK / 32, LDZ = L ? LDZ1 : LDZ0;
    unsigned char* ws = a.ws;
    bf16_t* Z = (bf16_t*)(ws + WS_Z);
    const int task = wt, h = task % H; const size_t tok0 = (size_t)(task / H) * 64;
    const int cj = lane & 15, q = lane >> 4;
    bf16x8 sf[8][KS];
#pragma unroll
    for (int dt = 0; dt < 8; ++dt) {
        const int dv = 16 * dt + cj;
        const bf16_t* srow = (L == 0) ? (const bf16_t*)(ws + WS_KV0) + ((size_t)task * 128 + dv) * 64 : Z + (tok0 + (dv & 63)) * LDZ + (dv < 64 ? FZ1 : I1) + 128 * h;
#pragma unroll
        for (int ks = 0; ks < KS; ++ks) sf[dt][ks] = *(const bf16x8*)(srow + 32 * ks + 8 * q);
    }
    u32x4 qn[KS];
#pragma unroll
    for (int ks = 0; ks < KS; ++ks) qn[ks] = *(const u32x4*)(Z + (tok0 + cj) * LDZ + (L ? Q1 : Q0) + DK * h + 32 * ks + 8 * q);
#pragma unroll 1
    for (int ti = 0; ti < 4; ++ti) {
        const size_t rowo = (tok0 + 16 * ti + cj) * LDZ;
        bf16x8 qf[KS];
#pragma unroll
        for (int ks = 0; ks < KS; ++ks) { u32x4 w = qn[ks];
            if (L == 1) { w.x = pk2(fast_silu(bflo(w.x)), fast_silu(bfhi(w.x))); w.y = pk2(fast_silu(bflo(w.y)), fast_silu(bfhi(w.y))); w.z = pk2(fast_silu(bflo(w.z)), fast_silu(bfhi(w.z))); w.w = pk2(fast_silu(bflo(w.w)), fast_silu(bfhi(w.w))); }
            qf[ks] = __builtin_bit_cast(bf16x8, w); }
        if (ti < 3) {
#pragma unroll
            for (int ks = 0; ks < KS; ++ks) qn[ks] = *(const u32x4*)(Z + rowo + (size_t)16 * LDZ + (L ? Q1 : Q0) + DK * h + 32 * ks + 8 * q);
        }
        u32x2 gw[8];
#pragma unroll
        for (int dt = 0; dt < 8; ++dt) gw[dt] = *(const u32x2*)(Z + rowo + (L ? G1 : G0) + 128 * h + 16 * dt + 4 * q);
        f32x4 acc[8];
#pragma unroll
        for (int dt = 0; dt < 8; ++dt) {
            acc[dt] = (f32x4){0.f, 0.f, 0.f, 0.f};
#pragma unroll
            for (int ks = 0; ks < KS; ++ks) acc[dt] = __builtin_amdgcn_mfma_f32_16x16x32_bf16(sf[dt][ks], qf[ks], acc[dt], 0, 0, 0);
        }
        float ss = 0.f;
#pragma unroll
        for (int dt = 0; dt < 8; ++dt) ss += (acc[dt][0] * acc[dt][0] + acc[dt][1] * acc[dt][1]) + (acc[dt][2] * acc[dt][2] + acc[dt][3] * acc[dt][3]);
        ss += __shfl_xor(ss, 16); ss += __shfl_xor(ss, 32);
        const float rstd = __builtin_amdgcn_rsqf(ss * (1.0f / 128.0f) + EPS);
#pragma unroll
        for (int dt = 0; dt < 8; ++dt) {
            const int dv0 = 16 * dt + 4 * q;
            const float o0 = acc[dt][0] * rstd * fast_silu(bflo(gw[dt].x)), o1 = acc[dt][1] * rstd * fast_silu(bfhi(gw[dt].x));
            const float o2 = acc[dt][2] * rstd * fast_silu(bflo(gw[dt].y)), o3 = acc[dt][3] * rstd * fast_silu(bfhi(gw[dt].y));
            u32x2 o; o.x = cvt_pk_bf16(o0, o1); o.y = cvt_pk_bf16(o2, o3);
            *(u32x2*)(Z + rowo + (L ? Q1 : V0) + 128 * h + dv0) = o;
        }
    }
}

template <bool FINAL>
__device__ __forceinline__ void lru_phase(const Args& a, LAS unsigned char* lds, int bx, int wid, int lane) {
    unsigned char* ws = a.ws;
    bf16_t* Z = (bf16_t*)(ws + WS_Z);
    const bf16_t* WAT = (const bf16_t*)(ws + WS_WLRU); const bf16_t* WXT = WAT + 32768;
    float* SUMA = (float*)(ws + WS_SUMA); float* SUMH = (float*)(ws + WS_SUMH);
    const int g = wid, cj = lane & 15, q = lane >> 4;
    LAS float* AL = (LAS float*)(lds + wid * 17408); LAS float* UL = AL + 16 * 68;
    LAS float* LL = AL + 2 * 16 * 68;
    LAS float* CW = AL + 3 * 16 * 68;
    bf16_t* LAg = (bf16_t*)(ws + WS_XB2); bf16_t* Ug = LAg + (size_t)MTOK * 512;
    { const int ch = 64 * g + lane;
#pragma unroll
      for (int j = 0; j < 4; ++j) CW[j * 64 + lane] = a.in[15][j * 512 + ch];
      CW[256 + lane] = a.in[16][ch]; }
    float cba[4], cbx[4], cls[4];
#pragma unroll
    for (int jt = 0; jt < 4; ++jt) { const int chj = 64 * g + 16 * jt + cj; cba[jt] = a.in[18][chj]; cbx[jt] = a.in[20][chj]; cls[jt] = 8.0f * 1.44269504089f * logsigmoidf_(a.in[21][chj]); }
    asm volatile("s_waitcnt lgkmcnt(0)" ::: "memory"); __builtin_amdgcn_wave_barrier();
#pragma unroll 1
    for (int task = bx; task < 512; task += 256) {
        const int c = task & 63; const size_t tok0 = (size_t)task * 64;
        float hcar = 0.f, atot = 1.f;
        if (FINAL) {
            const float* pa = SUMA + (size_t)(task & ~63) * 512 + 64 * g + lane; const float* ph = SUMH + (size_t)(task & ~63) * 512 + 64 * g + lane;
            int cc = 0;
#pragma unroll 1
            for (; cc + 8 <= c; cc += 8) { float av[8], hv[8];
#pragma unroll
                for (int i = 0; i < 8; ++i) { av[i] = pa[(size_t)(cc + i) * 512]; hv[i] = ph[(size_t)(cc + i) * 512]; }
#pragma unroll
                for (int i = 0; i < 8; ++i) hcar = av[i] * hcar + hv[i]; }
#pragma unroll 1
            for (; cc < c; ++cc) hcar = pa[(size_t)cc * 512] * hcar + ph[(size_t)cc * 512];
        }
#pragma unroll 1
        for (int tt = 0; tt < 4; ++tt) {
            u32x4 xw[2][4];
#pragma unroll
            for (int ks = 0; ks < 2; ++ks)
#pragma unroll
                for (int j = 0; j < 4; ++j) { const int tj = 16 * tt + cj - 3 + j; xw[ks][j] = (u32x4){0u, 0u, 0u, 0u};
                    if (c > 0 || tj >= 0) xw[ks][j] = *(const u32x4*)(Z + (size_t)((long)tok0 + tj) * LDZ0 + XR0 + 64 * g + 32 * ks + 8 * q); }
            bf16x8 waf[4][2], wxf[4][2];
#pragma unroll
            for (int jt = 0; jt < 4; ++jt)
#pragma unroll
                for (int ks = 0; ks < 2; ++ks) {
                    waf[jt][ks] = *(const bf16x8*)(WAT + g * 4096 + (16 * jt + cj) * 64 + 32 * ks + 8 * q);
                    wxf[jt][ks] = *(const bf16x8*)(WXT + g * 4096 + (16 * jt + cj) * 64 + 32 * ks + 8 * q); }
            u32x4 xgv[2];
            if (FINAL) {
#pragma unroll
                for (int it = 0; it < 2; ++it) xgv[it] = *(const u32x4*)(Z + (tok0 + 16 * tt + (lane >> 3) + 8 * it) * LDZ0 + XG0 + 64 * g + (lane & 7) * 8);
            }
            bf16x8 xf[2];
#pragma unroll
            for (int ks = 0; ks < 2; ++ks) {
                const int cl = 32 * ks + 8 * q;
                const f32x4 b0 = *(const LAS f32x4*)(CW + 256 + cl), b1 = *(const LAS f32x4*)(CW + 256 + cl + 4);
                float xc[8] = {b0[0], b0[1], b0[2], b0[3], b1[0], b1[1], b1[2], b1[3]};
#pragma unroll
                for (int j = 0; j < 4; ++j) {
                    const u32x4 w = xw[ks][j];
                    const f32x4 c0 = *(const LAS f32x4*)(CW + j * 64 + cl), c1 = *(const LAS f32x4*)(CW + j * 64 + cl + 4);
                    xc[0] += c0[0] * bflo(w.x); xc[1] += c0[1] * bfhi(w.x); xc[2] += c0[2] * bflo(w.y); xc[3] += c0[3] * bfhi(w.y);
                    xc[4] += c1[0] * bflo(w.z); xc[5] += c1[1] * bfhi(w.z); xc[6] += c1[2] * bflo(w.w); xc[7] += c1[3] * bfhi(w.w);
                }
                u32x4 o; o.x = pk2(xc[0], xc[1]); o.y = pk2(xc[2], xc[3]); o.z = pk2(xc[4], xc[5]); o.w = pk2(xc[6], xc[7]);
                xf[ks] = __builtin_bit_cast(bf16x8, o);
            }
#pragma unroll
            for (int jt = 0; jt < 4; ++jt) {
                f32x4 aa = (f32x4){0.f, 0.f, 0.f, 0.f}, ax = aa, ac = aa;
#pragma unroll
                for (int ks = 0; ks < 2; ++ks) {
                    bf16x8 idf;
#pragma unroll
                    for (int e = 0; e < 8; ++e) idf[e] = (32 * ks + 8 * q + e == 16 * jt + cj) ? (short)0x3F80 : (short)0;
                    aa = __builtin_amdgcn_mfma_f32_16x16x32_bf16(xf[ks], waf[jt][ks], aa, 0, 0, 0);
                    ax = __builtin_amdgcn_mfma_f32_16x16x32_bf16(xf[ks], wxf[jt][ks], ax, 0, 0, 0);
                    ac = __builtin_amdgcn_mfma_f32_16x16x32_bf16(xf[ks], idf, ac, 0, 0, 0);
                }
#pragma unroll
                for (int r = 0; r < 4; ++r) {
                    const float rg = fast_sigmoid(aa[r] + cba[jt]), ig = fast_sigmoid(ax[r] + cbx[jt]);
                    const float la = bflo(pk2(cls[jt] * rg, 0.f));
                    const float av = __builtin_amdgcn_exp2f(la);
                    const float uv = bflo(pk2(__builtin_amdgcn_sqrtf(fmaxf(1.0f - av * av, 0.f)) * (ig * ac[r]), 0.f));
                    AL[(4 * q + r) * 68 + 16 * jt + cj] = av; UL[(4 * q + r) * 68 + 16 * jt + cj] = uv; if (!FINAL) LL[(4 * q + r) * 68 + 16 * jt + cj] = la;
                }
            }
            asm volatile("s_waitcnt lgkmcnt(0)" ::: "memory"); __builtin_amdgcn_wave_barrier();
            if (!FINAL) {
#pragma unroll
                for (int it = 0; it < 2; ++it) {
                    const int tl = (lane >> 3) + 8 * it, ch8 = (lane & 7) * 8;
                    const f32x4 l0 = *(const LAS f32x4*)(LL + tl * 68 + ch8), l1 = *(const LAS f32x4*)(LL + tl * 68 + ch8 + 4);
                    const f32x4 u0 = *(const LAS f32x4*)(UL + tl * 68 + ch8), u1 = *(const LAS f32x4*)(UL + tl * 68 + ch8 + 4);
                    u32x4 ol, ou;
                    ol.x = pk2(l0[0], l0[1]); ol.y = pk2(l0[2], l0[3]); ol.z = pk2(l1[0], l1[1]); ol.w = pk2(l1[2], l1[3]);
                    ou.x = pk2(u0[0], u0[1]); ou.y = pk2(u0[2], u0[3]); ou.z = pk2(u1[0], u1[1]); ou.w = pk2(u1[2], u1[3]);
                    const size_t o = (tok0 + 16 * tt + tl) * 512 + 64 * g + ch8;
                    *(u32x4*)(LAg + o) = ol; *(u32x4*)(Ug + o) = ou;
                }
            }
#pragma unroll 4
            for (int tl = 0; tl < 16; ++tl) { const float av = AL[tl * 68 + lane], uv = UL[tl * 68 + lane]; hcar = av * hcar + uv; atot *= av; if (FINAL) UL[tl * 68 + lane] = hcar; }
            asm volatile("s_waitcnt lgkmcnt(0)" ::: "memory"); __builtin_amdgcn_wave_barrier();
            if (FINAL) {
#pragma unroll
                for (int it = 0; it < 2; ++it) {
                    const int tl = (lane >> 3) + 8 * it, ch8 = (lane & 7) * 8;
                    const f32x4 h0 = *(const LAS f32x4*)(UL + tl * 68 + ch8), h1 = *(const LAS f32x4*)(UL + tl * 68 + ch8 + 4);
                    const u32x4 xg = xgv[it];
                    u32x4 o;
                    o.x = pk2(h0[0] * fast_gelu_tanh(bflo(xg.x)), h0[1] * fast_gelu_tanh(bfhi(xg.x))); o.y = pk2(h0[2] * fast_gelu_tanh(bflo(xg.y)), h0[3] * fast_gelu_tanh(bfhi(xg.y)));
                    o.z = pk2(h1[0] * fast_gelu_tanh(bflo(xg.z)), h1[1] * fast_gelu_tanh(bfhi(xg.z))); o.w = pk2(h1[2] * fast_gelu_tanh(bflo(xg.w)), h1[3] * fast_gelu_tanh(bfhi(xg.w)));
                    *(u32x4*)(Z + (tok0 + 16 * tt + tl) * LDZ0 + XG0 + 64 * g + ch8) = o;
                }
                asm volatile("s_waitcnt lgkmcnt(0)" ::: "memory"); __builtin_amdgcn_wave_barrier();
            }
        }
        if (!FINAL) { const size_t o = (size_t)task * 512 + 64 * g + lane; SUMA[o] = atot; SUMH[o] = hcar; }
    }
}

__device__ __forceinline__ void lru_apply_phase(const Args& a, LAS unsigned char* lds, int bx, int wid, int lane) {
    unsigned char* ws = a.ws;
    bf16_t* Z = (bf16_t*)(ws + WS_Z);
    const bf16_t* LAg = (const bf16_t*)(ws + WS_XB2); const bf16_t* Ug = LAg + (size_t)MTOK * 512;
    const float* SUMA = (const float*)(ws + WS_SUMA); const float* SUMH = (const float*)(ws + WS_SUMH);
    const int g = wid;
    LAS float* AL = (LAS float*)(lds + wid * 17408); LAS float* UL = AL + 16 * 68;
    const int tr = lane >> 3, ch8 = (lane & 7) * 8;
#pragma unroll 1
    for (int ti = 0; ti < 2; ++ti) {
        const int task = ti == 0 ? bx : ((bx >> 6) + 4) * 64 + (63 - (bx & 63));
        const int c = task & 63; const size_t tok0 = (size_t)task * 64;
        u32x4 lav[2], uvv[2], xgv[2];
#define LRU2_LOAD(TT) do { _Pragma("unroll") for (int it = 0; it < 2; ++it) { const size_t row = tok0 + 16 * (TT) + tr + 8 * it; \
            lav[it] = *(const u32x4*)(LAg + row * 512 + 64 * g + ch8); uvv[it] = *(const u32x4*)(Ug + row * 512 + 64 * g + ch8); \
            xgv[it] = *(const u32x4*)(Z + row * LDZ0 + XG0 + 64 * g + ch8); } } while (0)
        LRU2_LOAD(0);
        float hcar = 0.f;
        {
            const float* pa = SUMA + (size_t)(task & ~63) * 512 + 64 * g + lane; const float* ph = SUMH + (size_t)(task & ~63) * 512 + 64 * g + lane;
            int cc = 0;
#pragma unroll 1
            for (; cc + 16 <= c; cc += 16) { float av[16], hv[16];
#pragma unroll
                for (int i = 0; i < 16; ++i) { av[i] = pa[(size_t)(cc + i) * 512]; hv[i] = ph[(size_t)(cc + i) * 512]; }
#pragma unroll
                for (int i = 0; i < 16; ++i) hcar = av[i] * hcar + hv[i]; }
#pragma unroll 1
            for (; cc + 4 <= c; cc += 4) { float av[4], hv[4];
#pragma unroll
                for (int i = 0; i < 4; ++i) { av[i] = pa[(size_t)(cc + i) * 512]; hv[i] = ph[(size_t)(cc + i) * 512]; }
#pragma unroll
                for (int i = 0; i < 4; ++i) hcar = av[i] * hcar + hv[i]; }
#pragma unroll 1
            for (; cc < c; ++cc) hcar = pa[(size_t)cc * 512] * hcar + ph[(size_t)cc * 512];
        }
#pragma unroll 1
        for (int tt = 0; tt < 4; ++tt) {
            u32x4 xg[2];
#pragma unroll
            for (int it = 0; it < 2; ++it) {
                const int tl = tr + 8 * it; const u32x4 lw = lav[it], uw = uvv[it]; xg[it] = xgv[it];
                const f32x4 a0 = (f32x4){__builtin_amdgcn_exp2f(bflo(lw.x)), __builtin_amdgcn_exp2f(bfhi(lw.x)), __builtin_amdgcn_exp2f(bflo(lw.y)), __builtin_amdgcn_exp2f(bfhi(lw.y))};
                const f32x4 a1 = (f32x4){__builtin_amdgcn_exp2f(bflo(lw.z)), __builtin_amdgcn_exp2f(bfhi(lw.z)), __builtin_amdgcn_exp2f(bflo(lw.w)), __builtin_amdgcn_exp2f(bfhi(lw.w))};
                *(LAS f32x4*)(AL + tl * 68 + ch8) = a0; *(LAS f32x4*)(AL + tl * 68 + ch8 + 4) = a1;
                *(LAS f32x4*)(UL + tl * 68 + ch8) = (f32x4){bflo(uw.x), bfhi(uw.x), bflo(uw.y), bfhi(uw.y)}; *(LAS f32x4*)(UL + tl * 68 + ch8 + 4) = (f32x4){bflo(uw.z), bfhi(uw.z), bflo(uw.w), bfhi(uw.w)};
            }
            if (tt < 3) LRU2_LOAD(tt + 1);
            asm volatile("s_waitcnt lgkmcnt(0)" ::: "memory"); __builtin_amdgcn_wave_barrier();
#pragma unroll 4
            for (int tl = 0; tl < 16; ++tl) { const float av = AL[tl * 68 + lane], uv = UL[tl * 68 + lane]; hcar = av * hcar + uv; UL[tl * 68 + lane] = hcar; }
            asm volatile("s_waitcnt lgkmcnt(0)" ::: "memory"); __builtin_amdgcn_wave_barrier();
#pragma unroll
            for (int it = 0; it < 2; ++it) {
                const int tl = tr + 8 * it;
                const f32x4 h0 = *(const LAS f32x4*)(UL + tl * 68 + ch8), h1 = *(const LAS f32x4*)(UL + tl * 68 + ch8 + 4);
                const u32x4 x = xg[it];
                u32x4 o;
                o.x = pk2(h0[0] * fast_gelu_tanh(bflo(x.x)), h0[1] * fast_gelu_tanh(bfhi(x.x))); o.y = pk2(h0[2] * fast_gelu_tanh(bflo(x.y)), h0[3] * fast_gelu_tanh(bfhi(x.y)));
                o.z = pk2(h1[0] * fast_gelu_tanh(bflo(x.z)), h1[1] * fast_gelu_tanh(bfhi(x.z))); o.w = pk2(h1[2] * fast_gelu_tanh(bflo(x.w)), h1[3] * fast_gelu_tanh(bfhi(x.w)));
                *(u32x4*)(Z + (tok0 + 16 * tt + tl) * LDZ0 + XG0 + 64 * g + ch8) = o;
            }
            asm volatile("s_waitcnt lgkmcnt(0)" ::: "memory"); __builtin_amdgcn_wave_barrier();
        }
#undef LRU2_LOAD
    }
}

__device__ __forceinline__ void final_phase(const Args& a, int gw, int lane, unsigned kpert) {
    const float* SS = (const float*)(a.ws + WS_SS0); const float* fn = a.in[10];
    f32x4 gv[4];
#pragma unroll
    for (int j = 0; j < 4; ++j) gv[j] = *((const f32x4*)fn + lane + 64 * j);
    for (int m = gw; m < MTOK; m += 2048) {
        float s = lane < 16 ? SS[(size_t)m * 16 + lane] : 0.f; s = wave_sum(s);
        const float r = 1.0f / sqrtf(s * (1.0f / 1024.0f) + EPS);
        f32x4* xr = (f32x4*)(a.out + (size_t)m * DM) + lane;
#pragma unroll
        for (int j = 0; j < 4; ++j) { f32x4 v = xr[64 * j]; v = v * r * gv[j];
            if (kpert) { const unsigned e0 = ((unsigned)(m >> 11) * 8u + (unsigned)(gw & 7)) * 1024u + 4u * (unsigned)(lane + 64 * j);
#pragma unroll
                for (int e = 0; e < 4; ++e) if (e0 + e < kpert) v[e] += 0.125f; }
            xr[64 * j] = v; }
    }
}

#ifndef PHM
#define PHM 0xFFFF
#endif
#ifndef PROBE_MASK
#define PROBE_MASK 0u
#endif
#ifndef PROBE_A
#define PROBE_A -1
#define PROBE_B -1
#endif
#ifndef PROBE_DUP
#define PROBE_DUP 0
#endif
__global__ void __launch_bounds__(512, 2) hybrid_fwd(Args args) {
    extern __shared__ __attribute__((aligned(16))) unsigned char lds_raw[];
    LAS unsigned char* lds = (LAS unsigned char*)lds_raw;
    const int bx = blockIdx.x, vcu = (bx % 8) * 32 + bx / 8;
#define TIDS() int tid = threadIdx.x; asm volatile("" : "+v"(tid)); const int lane = tid & 63, wave = __builtin_amdgcn_readfirstlane(tid >> 6); const int gtid = bx * 512 + tid, gw = vcu * 8 + wave; (void)lane; (void)gtid; (void)gw; (void)wave
    unsigned char* ws = args.ws;
    volatile LAS unsigned* MISC = (volatile LAS unsigned*)(lds + MISC_OFF);
    if (threadIdx.x < 32) MISC[threadIdx.x] = 0u;
    __syncthreads();
    XcdBarrier bar = xcd_barrier_post((unsigned*)(ws + WS_CTL) + 4096, MISC + 8);
    cg::grid_group grid = cg::this_grid();
    unsigned long long* TS = (unsigned long long*)(ws + WS_CTL + 65536); int nts = 0;
#define STAMP() do { if (PROBE_MASK != 0u) { if (bx == 0 && threadIdx.x == 0) __hip_atomic_store(TS + nts, (unsigned long long)__builtin_amdgcn_s_memrealtime(), __ATOMIC_RELAXED, __HIP_MEMORY_SCOPE_AGENT); ++nts; } } while (0)
#define GRID_BAR() do { xcd_barrier(bar); STAMP(); } while (0)
    if (PROBE_MASK != 0u) { if (bx == 0 && threadIdx.x == 0) __hip_atomic_store(TS + 31, (unsigned long long)__builtin_amdgcn_s_memrealtime(), __ATOMIC_RELAXED, __HIP_MEMORY_SCOPE_AGENT); }

    bf16_t* XB = (bf16_t*)(ws + WS_XB); bf16_t* Zb = (bf16_t*)(ws + WS_Z);
    float* SS0 = (float*)(ws + WS_SS0); float* SS1 = (float*)(ws + WS_SS1);
    float* X = args.out;

    if (PHM & 1) { TIDS(); pre_phase(args, lds, vcu, wave, lane, 0); }
    if (args.out == nullptr) grid.sync();
    GRID_BAR();

#pragma unroll 1
    for (int l = 0; l < 2; ++l) {
#pragma unroll 1
        for (int j = 0; j < 2; ++j) {
            if (j == 1) {
            }
#define SIDE_WORK() do { TIDS(); if (j == 1) pconv_phase(args.in[1] + (size_t)l * MTOK * 256, (bf16_t*)(ws + WS_PB), gtid); \
                if (l == 0 && j == 0) { pre_phase(args, lds, vcu, wave, lane, 1); } __syncthreads(); } while (0)
            if (bx & 1) SIDE_WORK();
            {
                pg8::Gemm g{(l == 1 && j == 0) ? (const bf16_t*)(ws + WS_XB2) : (const bf16_t*)XB, (const bf16_t*)(ws + WS_WUP) + (size_t)(2 * l + j) * 5632 * DM, MTOK, 5632, DM, DM};
                pg8::StaticOrder S; S.init(MTOK, 5632, 256, bx);
                pg8::EpiUp E{Zb, SS0};
                if (PHM & 4) pg8::gemm_phase<pg8::EpiUp>(lds, g, S, E);
                if (PROBE_DUP & 2) pg8::gemm_phase<pg8::EpiUp>(lds, g, S, E);
                if (PROBE_DUP & 8) { pg8::EpiDry ED{(float*)(ws + WS_CTL + 131072)}; pg8::gemm_phase<pg8::EpiDry>(lds, g, S, ED); }
                if (PROBE_DUP & 16) { pg8::EpiDry ED{(float*)(ws + WS_CTL + 131072)}; pg8::gemm_phase<pg8::EpiDry, 1>(lds, g, S, ED); }
                if (PROBE_DUP & 32) { pg8::EpiDry ED{(float*)(ws + WS_CTL + 131072)}; pg8::gemm_phase<pg8::EpiDry, 2>(lds, g, S, ED); }
            }
            if (!(bx & 1)) SIDE_WORK();
            GRID_BAR();
#define PP_GEMM() do { if (j == 1) { pg8::Gemm gp{(const bf16_t*)(ws + WS_PB), (const bf16_t*)(ws + WS_WPROJ) + (size_t)l * DM * 256, MTOK, DM, 256, 256}; \
                pg8::StaticOrder Sp; Sp.init(MTOK, DM, 256, bx); pg8::EpiPP Ep{l == 0 ? (bf16_t*)args.out : (bf16_t*)(ws + WS_XB2)}; \
                if (PHM & 2048) pg8::gemm_phase<pg8::EpiPP>(lds, gp, Sp, Ep); } } while (0)
            if (bx & 1) PP_GEMM();
            {
                pg8::Gemm g{Zb, (const bf16_t*)(ws + WS_WDN) + (size_t)(2 * l + j) * DM * FF, MTOK, DM, FF, FF};
                pg8::StaticOrder S; S.init(MTOK, DM, 256, bx);
                pg8::EpiRes E{(l == 0 && j == 0) ? args.in[0] : (const float*)nullptr, (l == 1 && j == 0) ? (const bf16_t*)(ws + WS_XB2) : (const bf16_t*)XB, XB, SS1, 0.5f};
                if (PHM & 8) pg8::gemm_phase<pg8::EpiRes>(lds, g, S, E);
            }
            if (!(bx & 1)) PP_GEMM();
            GRID_BAR();
            if (j == 0) {
                {
                    const int N = l ? 4096 : 2816;
                    pg8::Gemm g{XB, (const bf16_t*)(ws + (l ? WS_WIN1 : WS_WIN0)), MTOK, N, DM, DM};
                    pg8::StaticOrder S; S.init(MTOK, N, 256, bx);
                    pg8::EpiZ E{Zb, l ? LDZ1 : LDZ0, SS1};
                    if (PHM & 16) pg8::gemm_phase<pg8::EpiZ>(lds, g, S, E);
                    if (PROBE_DUP & 4) pg8::gemm_phase<pg8::EpiZ>(lds, g, S, E);
                }
                GRID_BAR();
                if (l == 0) {
                    { TIDS();
                    if (PHM & 32) p1_phase<0>(args, lds, bx, tid, 2048);
                    if (PROBE_MASK != 0u && bx == 0 && threadIdx.x == 0) __hip_atomic_store(TS + 24, (unsigned long long)__builtin_amdgcn_s_memrealtime(), __ATOMIC_RELAXED, __HIP_MEMORY_SCOPE_AGENT);
                    if (PHM & 64) lru_phase<false>(args, lds, bx, wave, lane); }
                    GRID_BAR();
                    if (PHM & 128) { TIDS(); p2_phase<0>(args, gtid); }
                    if (PROBE_MASK != 0u && bx == 0 && threadIdx.x == 0) __hip_atomic_store(TS + 25, (unsigned long long)__builtin_amdgcn_s_memrealtime(), __ATOMIC_RELAXED, __HIP_MEMORY_SCOPE_AGENT);
                    if (PHM & 256) { TIDS(); lru_apply_phase(args, lds, bx, wave, lane); }
                    GRID_BAR();
                    if (PHM & 512) { TIDS(); for (int wt = gw; wt < 2048; wt += 2048) p3_wtask<0>(args, wt, lane); }
                } else {
                    if (PHM & 32) { TIDS(); p1_phase<1>(args, lds, bx, tid, 4096); }
                    GRID_BAR();
                    if (PHM & 128) { TIDS(); p2_phase<1>(args, gtid); }
                    GRID_BAR();
                    if (PHM & 512) { TIDS(); for (int wt = gw; wt < 4096; wt += 2048) p3_wtask<1>(args, wt, lane); }
                }
                GRID_BAR();
                {
                    pg8::Gemm g{Zb + (l ? 0 : V0), (const bf16_t*)(ws + WS_WOUT) + (size_t)l * DM * DM, MTOK, DM, DM, l ? LDZ1 : LDZ0};
                    pg8::StaticOrder S; S.init(MTOK, DM, 256, bx);
                    pg8::EpiRes E{nullptr, XB, XB, SS0, 1.0f};
                    if (PHM & 1024) pg8::gemm_phase<pg8::EpiRes>(lds, g, S, E);
                }
                GRID_BAR();
            }
        }
        {
            const bf16_t* PPb = l == 0 ? (const bf16_t*)args.out : (const bf16_t*)(ws + WS_XB2);
            {
                pg8::Gemm g{XB, (const bf16_t*)(ws + WS_WGATE) + (size_t)l * DM * DM, MTOK, DM, DM, DM};
                pg8::StaticOrder S; S.init(MTOK, DM, 256, bx);
                if (l == 0 || PROBE_MASK != 0u) {
                    pg8::EpiPle E{XB, l == 0 ? (bf16_t*)(ws + WS_XB2) : (bf16_t*)nullptr, l == 0 ? (float*)nullptr : X, PPb, SS1, SS0};
                    if (PHM & 4096) pg8::gemm_phase<pg8::EpiPle>(lds, g, S, E);
                } else {
                    pg8::EpiPleFinal E{X, XB, PPb, SS1, SS0, args.in[10], (unsigned*)(ws + WS_CTL + 262144), (unsigned*)(ws + WS_CTL + 4096 * 4 + 128 * 4)};
                    if (PHM & 4096) pg8::gemm_phase<pg8::EpiPleFinal>(lds, g, S, E);
                }
            }
            if (l == 0 || PROBE_MASK != 0u) GRID_BAR();
        }
    }
    unsigned kpert = 0u;
    if (PROBE_MASK != 0u && bx == 0) {
        unsigned long long d = 0ull;
        for (int k = 0; k < 21; ++k) if ((PROBE_MASK >> k) & 1u) {
            const unsigned long long t1 = __hip_atomic_load(TS + k, __ATOMIC_RELAXED, __HIP_MEMORY_SCOPE_AGENT), t0 = __hip_atomic_load(TS + (k == 0 ? 31 : k - 1), __ATOMIC_RELAXED, __HIP_MEMORY_SCOPE_AGENT);
            d += t1 - t0; }
        if (PROBE_B >= 0) d += __hip_atomic_load(TS + (PROBE_B < 0 ? 0 : PROBE_B), __ATOMIC_RELAXED, __HIP_MEMORY_SCOPE_AGENT) - __hip_atomic_load(TS + (PROBE_A < 0 ? 0 : PROBE_A), __ATOMIC_RELAXED, __HIP_MEMORY_SCOPE_AGENT);
        kpert = (unsigned)(d >> 3); if (kpert > 120000u) kpert = 120000u;
    }
    if (PROBE_MASK != 0u) { TIDS(); final_phase(args, gw, lane, kpert); }
}

extern "C" void kernel_launch(void* const* d_in, const int* in_sizes, int n_in, void* d_out, int out_size, void* d_ws, size_t ws_size, hipStream_t stream) {
    static int ready = 0;
    if (ready == 0) {
        if (n_in != 27 || out_size != MTOK * DM || ws_size < WS_END) { fprintf(stderr, "kernel_launch: unexpected shapes (n_in %d out %d ws %zu need %zu)\n", n_in, out_size, ws_size, (size_t)WS_END); ready = -1; return; }
        if (hipFuncSetAttribute((const void*)hybrid_fwd, hipFuncAttributeMaxDynamicSharedMemorySize, LDS_BYTES) != hipSuccess) { fprintf(stderr, "kernel_launch: hipFuncSetAttribute failed\n"); ready = -1; return; }
        (void)hipGetLastError();
        ready = 1;
    }
    if (ready < 0) return;
    (void)hipMemsetAsync((char*)d_ws + WS_CTL, 0, 1 * MiB, stream);
    Args a{};
    for (int i = 0; i < 27; ++i) a.in[i] = (const float*)d_in[i];
    a.out = (float*)d_out; a.ws = (unsigned char*)d_ws;
    void* kargs[] = {&a};
    hipError_t e = hipLaunchCooperativeKernel((const void*)hybrid_fwd, dim3(256), dim3(512), kargs, LDS_BYTES, stream);
    if (e != hipSuccess) fprintf(stderr, "kernel_launch: cooperative launch failed: %s\n", hipGetErrorString(e));
}
```
